# Optimizing an MI355X kernel written in HIP

```python
import math
import jax, jax.numpy as jnp
from jax import lax
import numpy as np

D_MODEL = 1024
BATCH = 8
SEQ = 8192
DEPTH = 2

MIX_WIDTH = D_MODEL
CONV_WIDTH = MIX_WIDTH // 2
SSM_WIDTH = MIX_WIDTH - CONV_WIDTH
CONV_KERNEL = 31
SSM_GROUP = 16
SSM_GROUPS = SSM_WIDTH // SSM_GROUP
SSM_STATE = 64
IN_COLS = 2 * CONV_WIDTH + SSM_WIDTH
FFN_HIDDEN = ((8 * D_MODEL + 3 * 256 - 1) // (3 * 256)) * 256
DT_MIN = 1e-3
DT_MAX = 1e-1
NORM_EPS = 1e-6

kernel_name = "hybrid_conformer_s5_parallel_encoder"


def rms_norm(x, g):
    xf = x.astype(jnp.float32)
    y = xf * lax.rsqrt(jnp.mean(xf * xf, axis=-1, keepdims=True) + NORM_EPS)
    return (y * g.astype(jnp.float32)).astype(x.dtype)


def layer_norm(x, g, b):
    xf = x.astype(jnp.float32)
    mu = jnp.mean(xf, axis=-1, keepdims=True)
    var = jnp.mean(jnp.square(xf - mu), axis=-1, keepdims=True)
    y = (xf - mu) * lax.rsqrt(var + NORM_EPS)
    return (y * g.astype(jnp.float32) + b.astype(jnp.float32)).astype(x.dtype)


def depthwise_conv(h, w, b):
    c = h.shape[-1]
    y = lax.conv_general_dilated(
        h, w[:, None, :].astype(h.dtype), window_strides=(1,),
        padding=[(CONV_KERNEL // 2, CONV_KERNEL // 2)],
        dimension_numbers=("NWC", "WIO", "NWC"), feature_group_count=c)
    return y + b.astype(h.dtype)


def _linear_combine(e1, e2):
    a1, b1 = e1
    a2, b2 = e2
    return a2 * a1, a2 * b1 + b2


def s5_direction(u_c, a_re, a_im, log_dt, b_re, b_im, c_re, c_im, reverse):
    f32 = jnp.float32
    lam = lax.complex(a_re.astype(f32), a_im.astype(f32))
    dt = jnp.exp(log_dt.astype(f32))[:, None]
    a_bar = jnp.exp(lam * dt)
    b_bar = ((a_bar - 1.0) / lam)[:, :, None] * lax.complex(b_re.astype(f32), b_im.astype(f32))
    bu = jnp.einsum("blgh,gph->blgp", u_c, b_bar)
    a_seq = jnp.broadcast_to(a_bar, (1, u_c.shape[1]) + a_bar.shape)
    _, states = lax.associative_scan(_linear_combine, (a_seq, bu), reverse=reverse, axis=1)
    c_mat = lax.complex(c_re.astype(f32), c_im.astype(f32))
    return jnp.real(jnp.einsum("blgp,ghp->blgh", states, c_mat))


def s5_mixer(u, a_re, a_im, log_dt, b_re, b_im, c_re, c_im, d_skip, glu_w, glu_b):
    bsz, length, _ = u.shape
    uf = u.astype(jnp.float32).reshape(bsz, length, SSM_GROUPS, SSM_GROUP)
    u_c = uf.astype(jnp.complex64)
    y_fwd = s5_direction(u_c, a_re[0], a_im[0], log_dt[0], b_re[0], b_im[0], c_re[0], c_im[0], False)
    y_bwd = s5_direction(u_c, a_re[1], a_im[1], log_dt[1], b_re[1], b_im[1], c_re[1], c_im[1], True)
    y = (y_fwd + y_bwd).reshape(bsz, length, SSM_WIDTH) + d_skip.astype(jnp.float32) * uf.reshape(bsz, length, SSM_WIDTH)
    z = jax.nn.gelu(y)
    z = z * jax.nn.sigmoid(z @ glu_w.astype(jnp.float32) + glu_b.astype(jnp.float32))
    return z.astype(u.dtype)


def setup_inputs(seed: int = 0) -> dict:
    key = jax.random.key(seed)
    ks = jax.random.split(key, 24)
    f32 = jnp.float32
    L2 = (DEPTH, 2)

    def nrm(k, shape, scale):
        return jax.random.normal(k, shape, f32) * scale

    def gain(k, shape):
        return 1.0 + 0.05 * jax.random.normal(k, shape, f32)

    n_idx = jnp.arange(SSM_STATE, dtype=f32)
    a_im_base = jnp.broadcast_to(math.pi * n_idx, L2 + (SSM_GROUPS, SSM_STATE))
    return {
        "x": jax.random.normal(ks[0], (BATCH, SEQ, D_MODEL), f32),
        "mix_norm_pre": gain(ks[1], (DEPTH, D_MODEL)),
        "mix_norm_post": gain(ks[2], (DEPTH, D_MODEL)),
        "w_in": nrm(ks[3], (DEPTH, D_MODEL, IN_COLS), D_MODEL ** -0.5),
        "conv_dw_w": nrm(ks[4], (DEPTH, CONV_KERNEL, CONV_WIDTH), CONV_KERNEL ** -0.5),
        "conv_dw_b": nrm(ks[5], (DEPTH, CONV_WIDTH), 0.02),
        "conv_ln_g": gain(ks[6], (DEPTH, CONV_WIDTH)),
        "conv_ln_b": nrm(ks[7], (DEPTH, CONV_WIDTH), 0.02),
        "ssm_a_re": -0.5 + 0.01 * jax.random.normal(ks[8], L2 + (SSM_GROUPS, SSM_STATE), f32),
        "ssm_a_im": a_im_base + 0.01 * jax.random.normal(ks[9], L2 + (SSM_GROUPS, SSM_STATE), f32),
        "ssm_log_dt": jax.random.uniform(ks[10], L2 + (SSM_GROUPS,), f32, math.log(DT_MIN), math.log(DT_MAX)),
        "ssm_b_re": nrm(ks[11], L2 + (SSM_GROUPS, SSM_STATE, SSM_GROUP), (2 * SSM_GROUP) ** -0.5),
        "ssm_b_im": nrm(ks[12], L2 + (SSM_GROUPS, SSM_STATE, SSM_GROUP), (2 * SSM_GROUP) ** -0.5),
        "ssm_c_re": nrm(ks[13], L2 + (SSM_GROUPS, SSM_GROUP, SSM_STATE), (2 * SSM_STATE) ** -0.5),
        "ssm_c_im": nrm(ks[14], L2 + (SSM_GROUPS, SSM_GROUP, SSM_STATE), (2 * SSM_STATE) ** -0.5),
        "ssm_d": nrm(ks[15], (DEPTH, SSM_WIDTH), 1.0),
        "ssm_glu_w": nrm(ks[16], (DEPTH, SSM_WIDTH, SSM_WIDTH), SSM_WIDTH ** -0.5),
        "ssm_glu_b": nrm(ks[17], (DEPTH, SSM_WIDTH), 0.02),
        "w_out": nrm(ks[18], (DEPTH, MIX_WIDTH, D_MODEL), MIX_WIDTH ** -0.5),
        "ffn_norm_pre": gain(ks[19], (DEPTH, D_MODEL)),
        "ffn_norm_post": gain(ks[20], (DEPTH, D_MODEL)),
        "ffn_w_gate": nrm(ks[21], (DEPTH, D_MODEL, FFN_HIDDEN), D_MODEL ** -0.5),
        "ffn_w_up": nrm(ks[22], (DEPTH, D_MODEL, FFN_HIDDEN), D_MODEL ** -0.5),
        "ffn_w_down": nrm(ks[23], (DEPTH, FFN_HIDDEN, D_MODEL), FFN_HIDDEN ** -0.5),
    }


def reference(x, mix_norm_pre, mix_norm_post, w_in, conv_dw_w, conv_dw_b, conv_ln_g, conv_ln_b,
              ssm_a_re, ssm_a_im, ssm_log_dt, ssm_b_re, ssm_b_im, ssm_c_re, ssm_c_im, ssm_d,
              ssm_glu_w, ssm_glu_b, w_out, ffn_norm_pre, ffn_norm_post, ffn_w_gate, ffn_w_up,
              ffn_w_down):
    for layer in range(DEPTH):
        h = rms_norm(x, mix_norm_pre[layer])
        proj = h @ w_in[layer]
        conv_val = proj[..., :CONV_WIDTH]
        conv_gate = proj[..., CONV_WIDTH:2 * CONV_WIDTH]
        u = proj[..., 2 * CONV_WIDTH:]
        c = conv_val * jax.nn.sigmoid(conv_gate)
        c = depthwise_conv(c, conv_dw_w[layer], conv_dw_b[layer])
        c = jax.nn.silu(layer_norm(c, conv_ln_g[layer], conv_ln_b[layer]))
        s = s5_mixer(u, ssm_a_re[layer], ssm_a_im[layer], ssm_log_dt[layer], ssm_b_re[layer],
                     ssm_b_im[layer], ssm_c_re[layer], ssm_c_im[layer], ssm_d[layer],
                     ssm_glu_w[layer], ssm_glu_b[layer])
        mixed = jnp.concatenate([c, s.astype(c.dtype)], axis=-1) @ w_out[layer]
        x = x + rms_norm(mixed, mix_norm_post[layer])
        h = rms_norm(x, ffn_norm_pre[layer])
        f = (jax.nn.silu(h @ ffn_w_gate[layer]) * (h @ ffn_w_up[layer])) @ ffn_w_down[layer]
        x = x + rms_norm(f, ffn_norm_post[layer])
    return x
```

```cpp
#include <hip/hip_runtime.h>
#include <hip/hip_cooperative_groups.h>
#include <cstdio>
#include <cstdint>
namespace cg = cooperative_groups;

namespace pg8 {
#define PG8_LAS __attribute__((address_space(3)))
typedef unsigned short bf16_t;
typedef short bf16x8 __attribute__((ext_vector_type(8)));
typedef float f32x4 __attribute__((ext_vector_type(4)));
typedef unsigned u32x4 __attribute__((ext_vector_type(4)));
constexpr int BM = 256, BK = 64, HALF = 128, HTB = HALF * BK * 2, STAGE_BYTES = 8 * HTB, NXCD = 8, WGM = 8;

__host__ __device__ __forceinline__ int lds_byte(int r, int c) { const int st = (r >> 4) * 2 + (c >> 5), rr = r & 15, cc = c & 31, ob = rr * 64 + cc * 2; return st * 1024 + (ob ^ (((ob >> 9) & 1) << 5)); }
__host__ __device__ __forceinline__ void stage_rc(int b, int& R, int& C) { const int st = b / 1024, sb = b % 1024, swz = sb ^ (((sb >> 9) & 1) << 5); R = (st >> 1) * 16 + swz / 64; C = (st & 1) * 32 + (swz % 64) / 2; }
__host__ __device__ __forceinline__ int perm32(int rho) { const int n = rho >> 4, i = rho & 15; return 8 * (i >> 2) + 4 * n + (i & 3); }

struct Unit { int pm, pn; };
struct Gemm { const bf16_t* A; const bf16_t* Bt; int lda, ldb, K; };

struct StaticOrder {
    int nM, nN, nwg, G, c;
    __host__ __device__ void init(int M, int N, int G_, int c_) { nM = M / BM; nN = N / BM; nwg = nM * nN; G = G_; c = c_; }
    __host__ __device__ bool next(int i, Unit& u) const {
        const long L = (long)i * G + c; if (L >= nwg) return false;
        int wgid = (int)L; { const int q = nwg / NXCD, r = nwg % NXCD, xcd = wgid % NXCD, off = wgid / NXCD; wgid = (xcd < r ? xcd * (q + 1) : r * (q + 1) + (xcd - r) * q) + off; }
        const int nig = WGM * nN, gid = wgid / nig, fm = gid * WGM, gsz = (nM - fm) < WGM ? (nM - fm) : WGM;
        u.pm = fm + ((wgid % nig) % gsz); u.pn = (wgid % nig) / gsz; return true;
    }
};

__device__ __forceinline__ unsigned cvt_pk_bf16(float lo, float hi) { unsigned r; asm volatile("v_cvt_pk_bf16_f32 %0, %1, %2" : "=v"(r) : "v"(lo), "v"(hi)); return r; }

template <class Epi, class Sched>
__device__ __forceinline__ void gemm_phase(PG8_LAS unsigned char* lds, const Gemm g, const Sched& S, const Epi& E) {
    int tid_ = threadIdx.x; asm volatile("" : "+v"(tid_));
    const int tid = tid_, wid = __builtin_amdgcn_readfirstlane(tid >> 6), lane = tid & 63, wr = wid >> 2, wc = wid & 3, fr = lane & 15, fq = lane >> 4;
    const int K = g.K, nt = K / BK;
    unsigned voffA[2], voffB[2];
#pragma unroll
    for (int i = 0; i < 2; ++i) { int R, C; stage_rc(tid * 16 + i * 8192, R, C); const int Rb = (R & ~31) + perm32(R & 31);
        voffA[i] = (unsigned)(R * g.lda + C) * 2u; voffB[i] = (unsigned)(Rb * g.ldb + C) * 2u; }
    const size_t kstep = (size_t)(BK * 2);
    const size_t hstepA = (size_t)HALF * g.lda * 2, hstepB = (size_t)HALF * g.ldb * 2;
    const size_t tstepA = 2 * hstepA, tstepB = 2 * hstepB;
    const unsigned ldsw = (unsigned)wid * 1024u;
    const int aoff = lds_byte(wr * 64 + fr, fq * 8), boff = lds_byte(wc * 32 + fr, fq * 8);
#define PG8_SA(b, h) (((b) * 2 + (h)) * HTB)
#define PG8_SB(b, h) ((4 + (b) * 2 + (h)) * HTB)
#define PG8_STAGE(bufoff, gbase, voff) do { _Pragma("unroll") for (int _i = 0; _i < 2; ++_i) \
        __builtin_amdgcn_global_load_lds((const unsigned*)((const char*)(gbase) + (voff)[_i]), (PG8_LAS unsigned*)(lds + (bufoff) + ldsw + _i * 8192), 16, 0, 0); } while (0)
#define PG8_LDA(dst, b, h) do { _Pragma("unroll") for (int m = 0; m < 4; ++m) _Pragma("unroll") for (int k = 0; k < 2; ++k) dst[m][k] = *(const PG8_LAS bf16x8*)(lds + PG8_SA(b, h) + aoff + m * 2048 + k * 1024); } while (0)
#define PG8_LDB(dst, b, h) do { _Pragma("unroll") for (int n = 0; n < 2; ++n) _Pragma("unroll") for (int k = 0; k < 2; ++k) dst[n][k] = *(const PG8_LAS bf16x8*)(lds + PG8_SB(b, h) + boff + n * 2048 + k * 1024); } while (0)
#define PG8_MMA(ai, bj, At, Bt) do { __builtin_amdgcn_s_setprio(1); _Pragma("unroll") for (int m = 0; m < 4; ++m) _Pragma("unroll") for (int n = 0; n < 2; ++n) _Pragma("unroll") for (int k = 0; k < 2; ++k) \
        acc[ai][bj][m][n] = __builtin_amdgcn_mfma_f32_16x16x32_bf16(Bt[n][k], At[m][k], acc[ai][bj][m][n], 0, 0, 0); __builtin_amdgcn_s_setprio(0); } while (0)
#define PG8_WAIT_V(n) asm volatile("s_waitcnt vmcnt(" #n ")" ::: "memory")
#define PG8_WAIT_L(n) asm volatile("s_waitcnt lgkmcnt(" #n ")" ::: "memory")
#define PG8_BAR __builtin_amdgcn_s_barrier()
#define PG8_SCHED __builtin_amdgcn_sched_barrier(0)
    Unit cur, nxt; int ui = 0;
    if (!S.next(0, cur)) return;
    f32x4 acc[2][2][4][2];
#pragma unroll
    for (int a = 0; a < 2; ++a)
#pragma unroll
        for (int b = 0; b < 2; ++b)
#pragma unroll
            for (int m = 0; m < 4; ++m)
#pragma unroll
                for (int n = 0; n < 2; ++n) acc[a][b][m][n] = (f32x4){0.f, 0.f, 0.f, 0.f};
    bf16x8 At[4][2], B0[2][2], B1[2][2];
    const char* cA = (const char*)g.A + (size_t)cur.pm * tstepA; const char* cB = (const char*)g.Bt + (size_t)cur.pn * tstepB;
    E.begin(cur, lds, tid);
    PG8_STAGE(PG8_SB(0, 0), cB, voffB); PG8_STAGE(PG8_SB(0, 1), cB + hstepB, voffB); PG8_STAGE(PG8_SA(0, 0), cA, voffA); PG8_STAGE(PG8_SA(0, 1), cA + hstepA, voffA);
    if (wr == 1) PG8_BAR;
    PG8_WAIT_V(2); PG8_BAR;
    PG8_STAGE(PG8_SB(1, 0), cB + kstep, voffB); PG8_STAGE(PG8_SA(1, 0), cA + kstep, voffA); PG8_STAGE(PG8_SB(1, 1), cB + hstepB + kstep, voffB);
    PG8_WAIT_V(6); PG8_BAR;
    for (;;) {
        const bool has_next = S.next(ui + 1, nxt);
        const char* nA = has_next ? (const char*)g.A + (size_t)nxt.pm * tstepA : cA; const char* nB = has_next ? (const char*)g.Bt + (size_t)nxt.pn * tstepB : cB;
        for (int t = 0; t < nt; t += 2) {
            const bool last = (t == nt - 2);
            const char* a1 = cA + (size_t)(t + 1) * kstep;
            const char* a2 = last ? nA : cA + (size_t)(t + 2) * kstep; const char* b2 = last ? nB : cB + (size_t)(t + 2) * kstep;
            const char* a3 = a2 + kstep; const char* b3 = b2 + kstep;
            PG8_LDB(B0, 0, 0); PG8_LDB(B1, 0, 1); PG8_SCHED; PG8_LDA(At, 0, 0); PG8_STAGE(PG8_SA(1, 1), a1 + hstepA, voffA);
            PG8_WAIT_V(8); PG8_WAIT_L(0); PG8_BAR; PG8_MMA(0, 0, At, B0); PG8_MMA(0, 1, At, B1); PG8_BAR; PG8_SCHED;
            PG8_LDA(At, 0, 1); PG8_STAGE(PG8_SB(0, 0), b2, voffB); PG8_STAGE(PG8_SB(0, 1), b2 + hstepB, voffB); PG8_STAGE(PG8_SA(0, 0), a2, voffA);
            PG8_WAIT_V(8); PG8_WAIT_L(0); PG8_BAR; PG8_MMA(1, 0, At, B0); PG8_MMA(1, 1, At, B1); PG8_BAR; PG8_SCHED;
            PG8_LDB(B0, 1, 0); PG8_LDB(B1, 1, 1); PG8_SCHED; PG8_LDA(At, 1, 0); PG8_STAGE(PG8_SA(0, 1), a2 + hstepA, voffA);
            PG8_WAIT_V(8); PG8_WAIT_L(0); PG8_BAR; PG8_MMA(0, 0, At, B0); PG8_MMA(0, 1, At, B1); PG8_BAR; PG8_SCHED;
            PG8_LDA(At, 1, 1); PG8_STAGE(PG8_SB(1, 0), b3, voffB); PG8_STAGE(PG8_SB(1, 1), b3 + hstepB, voffB); PG8_STAGE(PG8_SA(1, 0), a3, voffA);
            PG8_WAIT_V(8); PG8_WAIT_L(0); PG8_BAR; PG8_MMA(1, 0, At, B0); PG8_MMA(1, 1, At, B1); PG8_BAR; PG8_SCHED;
        }
        if (wr == 0) PG8_BAR;
        if constexpr (!Epi::AFTER_DRAIN) E(acc, cur, wr, wc, fr, fq, lds, wid, lane, nxt, has_next, ui);
        if (!has_next) break;
#pragma unroll
        for (int a = 0; a < 2; ++a)
#pragma unroll
            for (int b = 0; b < 2; ++b)
#pragma unroll
                for (int m = 0; m < 4; ++m)
#pragma unroll
                    for (int n = 0; n < 2; ++n) acc[a][b][m][n] = (f32x4){0.f, 0.f, 0.f, 0.f};
        cur = nxt; cA = nA; cB = nB; ++ui;
        if (wr == 1) PG8_BAR;
    }
    PG8_WAIT_V(0);
    PG8_BAR;
    if constexpr (Epi::AFTER_DRAIN) E.fused(acc, cur, wr, wc, fr, fq, lds, wid, lane);
#undef PG8_SA
#undef PG8_SB
#undef PG8_STAGE
#undef PG8_LDA
#undef PG8_LDB
#undef PG8_MMA
#undef PG8_WAIT_V
#undef PG8_WAIT_L
#undef PG8_BAR
#undef PG8_SCHED
}
}

#define GAS __attribute__((address_space(1)))
#define LAS __attribute__((address_space(3)))
typedef unsigned short bf16;
typedef unsigned v4u __attribute__((ext_vector_type(4)));
typedef unsigned v2u __attribute__((ext_vector_type(2)));
typedef float f32x4 __attribute__((ext_vector_type(4)));
typedef float f32x2 __attribute__((ext_vector_type(2)));
using pg8::cvt_pk_bf16;

constexpr int NWAVES = 8, NTHR = 512;
constexpr int DM = 1024, SEQ = 8192, NB = 8, M = NB * SEQ, DEPTH = 2;
constexpr int CW = 512, SW = 512, KC = 31, NG = 32, NP = 64, INC = 1536, FF = 2816;
constexpr int TC = 32;
constexpr int RPG = M / TC;
constexpr int K2 = TC * 16 + 256;
constexpr float EPS = 1e-6f;

constexpr size_t MiB = 1u << 20;
constexpr size_t WS_WL = 0, WL_STRIDE = 22 * MiB;
constexpr size_t OFF_WIN = 0, OFF_GLUW = 3 * MiB, OFF_WOUT = 3 * MiB + 512 * 1024, OFF_WGU = 5 * MiB + 512 * 1024, OFF_WDN = 16 * MiB + 512 * 1024;
constexpr size_t WS_S5 = 44 * MiB, S5_STRIDE = 32 * MiB;
constexpr size_t OFF_BS = 0, OFF_B2 = 8 * MiB;
constexpr size_t WS_ROWPART = 108 * MiB;
constexpr size_t WS_RSS = 116 * MiB;
constexpr size_t WS_BAR = 120 * MiB, BAR_REGION_WORDS = 4096, WS_XB = WS_BAR + 2 * MiB, BAR_BYTES = 4 * MiB;
constexpr size_t WS_AT = 112 * MiB;
constexpr size_t WS_H = 128 * MiB;
constexpr size_t WS_BIG = 256 * MiB;
constexpr size_t WS_CG = 608 * MiB, WS_Z = 672 * MiB, WS_A2 = 736 * MiB, WS_CAT = 832 * MiB;
constexpr size_t WS_END = 960 * MiB;
constexpr int LDS_BYTES = 147456;

struct Frame { LAS unsigned char* lds; int tid, lane, wave, vcu, G; };

__device__ __forceinline__ float wave_sum(float v) {
#pragma unroll
    for (int o = 1; o < 64; o <<= 1) v += __shfl_xor(v, o);
    return v;
}
__device__ __forceinline__ float wave_sum_dpp(float v) {
    v += __int_as_float(__builtin_amdgcn_update_dpp(0, __float_as_int(v), 0xB1, 0xf, 0xf, true));
    v += __int_as_float(__builtin_amdgcn_update_dpp(0, __float_as_int(v), 0x4E, 0xf, 0xf, true));
    v += __int_as_float(__builtin_amdgcn_update_dpp(0, __float_as_int(v), 0x141, 0xf, 0xf, true));
    v += __int_as_float(__builtin_amdgcn_update_dpp(0, __float_as_int(v), 0x140, 0xf, 0xf, true));
    const float r0 = __int_as_float(__builtin_amdgcn_readlane(__float_as_int(v), 0)), r1 = __int_as_float(__builtin_amdgcn_readlane(__float_as_int(v), 16));
    const float r2 = __int_as_float(__builtin_amdgcn_readlane(__float_as_int(v), 32)), r3 = __int_as_float(__builtin_amdgcn_readlane(__float_as_int(v), 48));
    return (r0 + r1) + (r2 + r3);
}
__device__ __forceinline__ float sum_rows4(float v) {
    const auto r = __builtin_amdgcn_permlane16_swap(__float_as_uint(v), __float_as_uint(v), false, false);
    const float a = __uint_as_float(r[0]) + __uint_as_float(r[1]);
    const auto q = __builtin_amdgcn_permlane32_swap(__float_as_uint(a), __float_as_uint(a), false, false);
    return __uint_as_float(q[0]) + __uint_as_float(q[1]);
}
__device__ __forceinline__ float sigmoid_f(float x) { return __builtin_amdgcn_rcpf(1.0f + __builtin_amdgcn_exp2f(-1.4426950408889634f * x)); }
__device__ __forceinline__ float bf_lo(unsigned w) { return __uint_as_float(w << 16); }
__device__ __forceinline__ float bf_hi(unsigned w) { return __uint_as_float(w & 0xffff0000u); }
__device__ __forceinline__ unsigned f2bf(float f) { unsigned u = __float_as_uint(f); return (u + 0x7fffu + ((u >> 16) & 1u)) >> 16; }
__device__ __forceinline__ unsigned pk2(float lo, float hi) { return f2bf(lo) | (f2bf(hi) << 16); }

#define XB_TMO      128
#define XB_XCNT(j)  (256  + 64 * (j))
#define XB_XSUB(j)  (1280 + 64 * (j))
#define XB_XGEN(j)  (2304 + 64 * (j))
#define XB_TOP      3328
#define XB_TOPGEN   3392
#define XCD_BAR_WORDS 3456
#define XB_SPIN_CAP (1u << 18)

__device__ __forceinline__ unsigned xb_ld(unsigned* p)              { return __hip_atomic_load(p, __ATOMIC_RELAXED, __HIP_MEMORY_SCOPE_AGENT); }
__device__ __forceinline__ unsigned xb_add(unsigned* p, unsigned v) { return __hip_atomic_fetch_add(p, v, __ATOMIC_RELAXED, __HIP_MEMORY_SCOPE_AGENT); }
__device__ __forceinline__ unsigned xb_xcc_id() { return (unsigned)__builtin_amdgcn_s_getreg((3 << 11) | 20) & 0xFu; }
#define XB_SPIN(cond, bar) do { unsigned _sp = 0; while (cond) { __builtin_amdgcn_s_sleep(1); \
    if ((++_sp & 255u) == 0u) { if (xb_ld(&(bar)[XB_TMO])) break; if (_sp > XB_SPIN_CAP) { atomicAdd(&(bar)[XB_TMO], 1u); break; } } } } while (0)

struct XcdBarrier {
    unsigned* bar; unsigned x; unsigned G;
    volatile LAS unsigned* st;
};

__device__ __forceinline__ XcdBarrier xcd_barrier_post(unsigned* bar, volatile LAS unsigned* st, unsigned G) {
    XcdBarrier b; b.bar = bar; b.x = xb_xcc_id(); b.st = st; b.G = G;
    if (threadIdx.x == 0) (void)xb_add(&bar[XB_XCNT(b.x)], 1u);
    return b;
}
__device__ __forceinline__ void xcd_barrier_complete(unsigned* bar, unsigned x, unsigned G, unsigned& nloc, unsigned& nx) {
    unsigned sum, cnt, mine, sp = 0u;
    for (;;) {
        sum = 0u; cnt = 0u; mine = 0u;
#pragma unroll
        for (unsigned j = 0; j < 16; ++j) { const unsigned c = xb_ld(&bar[XB_XCNT(j)]); sum += c; cnt += (c > 0u) ? 1u : 0u; mine = (j == x) ? c : mine; }
        if (sum == G) break;
        __builtin_amdgcn_s_sleep(1);
        if ((++sp & 255u) == 0u) { if (xb_ld(&bar[XB_TMO])) break; if (sp > XB_SPIN_CAP) { atomicAdd(&bar[XB_TMO], 1u); break; } }
    }
    nloc = mine > 0u ? mine : 1u; nx = cnt > 0u ? cnt : 1u;
}

__device__ __forceinline__ void xcd_barrier(const XcdBarrier& b) {
    asm volatile("s_waitcnt vmcnt(0)" ::: "memory");
    __syncthreads();
    if (threadIdx.x == 0) {
        unsigned* bar = b.bar;
        __builtin_amdgcn_s_waitcnt(0);
        unsigned nloc = b.st[0], nx = b.st[1];
        if (nloc == 0u) { xcd_barrier_complete(bar, b.x, b.G, nloc, nx); b.st[0] = nloc; b.st[1] = nx; }
        const unsigned old = xb_add(&bar[XB_XSUB(b.x)], 1u);
        const unsigned gen = old / nloc;
        if (old + 1u == (gen + 1u) * nloc) {
            __builtin_amdgcn_fence(__ATOMIC_RELEASE, "agent");
            asm volatile("s_waitcnt vmcnt(0)" ::: "memory");
            if (nx > 1u) {
            const unsigned og = xb_add(&bar[XB_TOP], 1u);
            const unsigned tg = og / nx;
            if (og + 1u == (tg + 1u) * nx) xb_add(&bar[XB_TOPGEN], 1u);
            else XB_SPIN(xb_ld(&bar[XB_TOPGEN]) == tg, bar);
            }
            __builtin_amdgcn_fence(__ATOMIC_ACQUIRE, "agent");
            xb_add(&bar[XB_XGEN(b.x)], 1u);
            asm volatile("s_waitcnt vmcnt(0)" ::: "memory");
        } else {
            XB_SPIN(xb_ld(&bar[XB_XGEN(b.x)]) == gen, bar);
            __builtin_amdgcn_fence(__ATOMIC_ACQUIRE, "agent");
            asm volatile("s_waitcnt vmcnt(0)" ::: "memory");
        }
    }
    __syncthreads();
}

constexpr int RS_OFF = 131072 + 10240;
__device__ __forceinline__ float rstd4(const f32x4 q) { return __builtin_amdgcn_rsqf(((q[0] + q[1]) + (q[2] + q[3])) * (1.0f / DM) + EPS); }
__device__ __forceinline__ void rowstat_begin(const float* rss, const pg8::Unit& cur, LAS unsigned char* lds, int tid) {
    if (tid < 256) ((LAS float*)(lds + RS_OFF))[tid] = rstd4(*(const f32x4*)(rss + ((size_t)cur.pm * 256 + tid) * 4));
}

struct EpiProj {
    static constexpr bool AFTER_DRAIN = false;
    __device__ __forceinline__ void begin(const pg8::Unit& cur, LAS unsigned char* lds, int tid) const { rowstat_begin(rss, cur, lds, tid); }
    bf16* CG; bf16* A2; const float* rss;
    __device__ __forceinline__ void operator()(const f32x4 (&acc)[2][2][4][2], const pg8::Unit& u, int wr, int wc, int fr, int fq, LAS unsigned char* lds, int wid, int lane, const pg8::Unit& nxt, bool has_next, int ui) const {
        const int row0 = u.pm * 256 + wr * 64 + fr, tid = wid * 64 + lane;
        const LAS float* R = (const LAS float*)(lds + RS_OFF) + (ui & 1) * 256;
        const bool pre = has_next && tid < 256; f32x4 qn = (f32x4){1.f, 1.f, 1.f, 1.f};
        if (pre) qn = *(const f32x4*)(rss + ((size_t)nxt.pm * 256 + tid) * 4);
        float rs[2][4];
#pragma unroll
        for (int ai = 0; ai < 2; ++ai)
#pragma unroll
            for (int m = 0; m < 4; ++m) rs[ai][m] = R[wr * 64 + fr + ai * 128 + m * 16];
        if (u.pn < 4) {
            const int col = u.pn * 128 + wc * 32 + fq * 8;
#pragma unroll
            for (int ai = 0; ai < 2; ++ai) {
#pragma unroll
                for (int m = 0; m < 4; ++m) {
                    const int row = row0 + ai * 128 + m * 16; const float r_ = rs[ai][m];
                    const f32x4 v0 = acc[ai][0][m][0] * r_, v1 = acc[ai][0][m][1] * r_, g0 = acc[ai][1][m][0] * r_, g1 = acc[ai][1][m][1] * r_;
                    v4u w;
                    w.x = cvt_pk_bf16(v0[0] * sigmoid_f(g0[0]), v0[1] * sigmoid_f(g0[1])); w.y = cvt_pk_bf16(v0[2] * sigmoid_f(g0[2]), v0[3] * sigmoid_f(g0[3]));
                    w.z = cvt_pk_bf16(v1[0] * sigmoid_f(g1[0]), v1[1] * sigmoid_f(g1[1])); w.w = cvt_pk_bf16(v1[2] * sigmoid_f(g1[2]), v1[3] * sigmoid_f(g1[3]));
                    *(v4u*)(CG + (size_t)row * CW + col) = w;
                }
                if (ai == 0) {
                    __builtin_amdgcn_sched_barrier(0);
                    float rn = rstd4(qn); asm volatile("" : "+v"(rn));
                    if (pre) ((LAS float*)(lds + RS_OFF))[((ui + 1) & 1) * 256 + tid] = rn;
                    __builtin_amdgcn_sched_barrier(0);
                }
            }
        } else {
#pragma unroll
            for (int ai = 0; ai < 2; ++ai) {
#pragma unroll
                for (int m = 0; m < 4; ++m) {
                    const int tok = row0 + ai * 128 + m * 16, r = tok >> 5, t = tok & 31;
#pragma unroll
                    for (int bj = 0; bj < 2; ++bj) {
                        const int cu = (u.pn - 4) * 256 + bj * 128 + wc * 32 + fq * 8, gg = cu >> 4, h0 = cu & 15;
                        const f32x4 v0 = acc[ai][bj][m][0] * rs[ai][m], v1 = acc[ai][bj][m][1] * rs[ai][m];
                        v4u w; w.x = cvt_pk_bf16(v0[0], v0[1]); w.y = cvt_pk_bf16(v0[2], v0[3]); w.z = cvt_pk_bf16(v1[0], v1[1]); w.w = cvt_pk_bf16(v1[2], v1[3]);
                        *(v4u*)(A2 + ((size_t)(gg * RPG + r) * K2 + t * 16 + h0)) = w;
                    }
                }
                if (ai == 0) {
                    __builtin_amdgcn_sched_barrier(0);
                    float rn = rstd4(qn); asm volatile("" : "+v"(rn));
                    if (pre) ((LAS float*)(lds + RS_OFF))[((ui + 1) & 1) * 256 + tid] = rn;
                    __builtin_amdgcn_sched_barrier(0);
                }
            }
        }
    }
};
struct EpiF32 {
    static constexpr bool AFTER_DRAIN = false;
    __device__ __forceinline__ void begin(const pg8::Unit&, LAS unsigned char*, int) const {}
    float* O;
    __device__ __forceinline__ void operator()(const f32x4 (&acc)[2][2][4][2], const pg8::Unit& u, int wr, int wc, int fr, int fq, LAS unsigned char* lds, int wid, int lane, const pg8::Unit& nxt, bool has_next, int ui) const {
        const int row0 = u.pm * 256 + wr * 64 + fr;
#pragma unroll
        for (int ai = 0; ai < 2; ++ai)
#pragma unroll
            for (int m = 0; m < 4; ++m) {
                float* rp = O + (size_t)(row0 + ai * 128 + m * 16) * 256 + wc * 32 + fq * 8;
#pragma unroll
                for (int bj = 0; bj < 2; ++bj) { *(f32x4*)(rp + bj * 128) = acc[ai][bj][m][0]; *(f32x4*)(rp + bj * 128 + 4) = acc[ai][bj][m][1]; }
            }
    }
};
struct EpiS5 {
    static constexpr bool AFTER_DRAIN = false;
    __device__ __forceinline__ void begin(const pg8::Unit&, LAS unsigned char*, int) const {}
    bf16* Z;
    __device__ __forceinline__ void operator()(const f32x4 (&acc)[2][2][4][2], const pg8::Unit& u, int wr, int wc, int fr, int fq, LAS unsigned char* lds, int wid, int lane, const pg8::Unit& nxt, bool has_next, int ui) const {
        const int gg = u.pm >> 3, pnl = u.pn & 1;
        const int rl0 = (u.pm & 7) * 256 + wr * 64 + fr;
#pragma unroll
        for (int ai = 0; ai < 2; ++ai)
#pragma unroll
            for (int m = 0; m < 4; ++m) {
                const int tok0 = (rl0 + ai * 128 + m * 16) * TC;
#pragma unroll
                for (int bj = 0; bj < 2; ++bj) {
                    const int t = 16 * pnl + 8 * bj + 2 * wc + (fq >> 1), h0 = 8 * (fq & 1);
                    float o[8];
#pragma unroll
                    for (int e = 0; e < 8; ++e) { const float y = acc[ai][bj][m][e >> 2][e & 3]; o[e] = y * sigmoid_f(1.5957691216f * y * (1.0f + 0.044715f * y * y)); }
                    v4u w; w.x = cvt_pk_bf16(o[0], o[1]); w.y = cvt_pk_bf16(o[2], o[3]); w.z = cvt_pk_bf16(o[4], o[5]); w.w = cvt_pk_bf16(o[6], o[7]);
                    *(v4u*)(Z + ((size_t)(tok0 + t) * SW + gg * 16 + h0)) = w;
                }
            }
    }
};
struct EpiGate {
    static constexpr bool AFTER_DRAIN = false;
    __device__ __forceinline__ void begin(const pg8::Unit&, LAS unsigned char*, int) const {}
    const bf16* Z; bf16* CAT; const float* bias;
    __device__ __forceinline__ void operator()(const f32x4 (&acc)[2][2][4][2], const pg8::Unit& u, int wr, int wc, int fr, int fq, LAS unsigned char* lds, int wid, int lane, const pg8::Unit& nxt, bool has_next, int ui) const {
        const int row0 = u.pm * 256 + wr * 64 + fr, col0 = u.pn * 256 + wc * 32 + fq * 8;
        f32x4 bv[2][2];
#pragma unroll
        for (int bj = 0; bj < 2; ++bj)
#pragma unroll
            for (int n = 0; n < 2; ++n) bv[bj][n] = *(const f32x4*)(bias + col0 + bj * 128 + 4 * n);
        v4u zall[2][4][2];
#pragma unroll
        for (int ai = 0; ai < 2; ++ai)
#pragma unroll
            for (int m = 0; m < 4; ++m)
#pragma unroll
                for (int bj = 0; bj < 2; ++bj) zall[ai][m][bj] = *(const v4u*)(Z + (size_t)(row0 + ai * 128 + m * 16) * SW + col0 + bj * 128);
#pragma unroll
        for (int ai = 0; ai < 2; ++ai)
#pragma unroll
            for (int m = 0; m < 4; ++m) {
                const int row = row0 + ai * 128 + m * 16;
#pragma unroll
                for (int bj = 0; bj < 2; ++bj) {
                    const int col = col0 + bj * 128;
                    const v4u zv = zall[ai][m][bj];
                    const f32x4 g0 = acc[ai][bj][m][0] + bv[bj][0], g1 = acc[ai][bj][m][1] + bv[bj][1];
                    v4u w;
                    w.x = cvt_pk_bf16(bf_lo(zv.x) * sigmoid_f(g0[0]), bf_hi(zv.x) * sigmoid_f(g0[1])); w.y = cvt_pk_bf16(bf_lo(zv.y) * sigmoid_f(g0[2]), bf_hi(zv.y) * sigmoid_f(g0[3]));
                    w.z = cvt_pk_bf16(bf_lo(zv.z) * sigmoid_f(g1[0]), bf_hi(zv.z) * sigmoid_f(g1[1])); w.w = cvt_pk_bf16(bf_lo(zv.w) * sigmoid_f(g1[2]), bf_hi(zv.w) * sigmoid_f(g1[3]));
                    *(v4u*)(CAT + (size_t)row * DM + SW + col) = w;
                }
            }
    }
};
struct EpiNormOut {
    static constexpr bool AFTER_DRAIN = false;
    __device__ __forceinline__ void begin(const pg8::Unit&, LAS unsigned char*, int) const {}
    bf16* O; float* rowpart;
    __device__ __forceinline__ void operator()(const f32x4 (&acc)[2][2][4][2], const pg8::Unit& u, int wr, int wc, int fr, int fq, LAS unsigned char* lds, int wid, int lane, const pg8::Unit& nxt, bool has_next, int ui) const {
        const int row0 = u.pm * 256 + wr * 64 + fr, col0 = u.pn * 256 + wc * 32 + fq * 8;
#pragma unroll
        for (int ai = 0; ai < 2; ++ai)
#pragma unroll
            for (int m = 0; m < 4; ++m) {
                const int row = row0 + ai * 128 + m * 16; float ss = 0.f;
#pragma unroll
                for (int bj = 0; bj < 2; ++bj) {
                    const f32x4 v0 = acc[ai][bj][m][0], v1 = acc[ai][bj][m][1];
                    ss += (v0[0] * v0[0] + v0[1] * v0[1]) + (v0[2] * v0[2] + v0[3] * v0[3]) + (v1[0] * v1[0] + v1[1] * v1[1]) + (v1[2] * v1[2] + v1[3] * v1[3]);
                    v4u w; w.x = cvt_pk_bf16(v0[0], v0[1]); w.y = cvt_pk_bf16(v0[2], v0[3]); w.z = cvt_pk_bf16(v1[0], v1[1]); w.w = cvt_pk_bf16(v1[2], v1[3]);
                    *(v4u*)(O + (size_t)row * DM + col0 + bj * 128) = w;
                }
                ss += __shfl_xor(ss, 16); ss += __shfl_xor(ss, 32);
                if (fq == 0) rowpart[(size_t)row * 16 + u.pn * 4 + wc] = ss;
            }
    }
};
template <bool FINAL>
struct EpiResNorm {
    static constexpr bool AFTER_DRAIN = false;
    __device__ __forceinline__ void begin(const pg8::Unit&, LAS unsigned char*, int) const {}
    bf16* X; const float* gpost; unsigned long long* xb; unsigned tag; float* rssp; float* out;
    __device__ __forceinline__ void operator()(const f32x4 (&acc)[2][2][4][2], const pg8::Unit& u, int wr, int wc, int fr, int fq, LAS unsigned char* lds, int wid, int lane, const pg8::Unit& nxt, bool has_next, int ui) const {
        LAS float* P = (LAS float*)(lds + 131072); LAS float* S = P + 1024; LAS float* Q = S + 256;
        const int tid = wid * 64 + lane, col0 = u.pn * 256 + wc * 32 + fq * 8, rl0 = wr * 64 + fr;
        const size_t rowbase = (size_t)u.pm * 256;
        v4u xv[4][2];
#pragma unroll
        for (int m = 0; m < 4; ++m)
#pragma unroll
            for (int bj = 0; bj < 2; ++bj) xv[m][bj] = *(const v4u*)(X + (rowbase + rl0 + m * 16) * DM + col0 + bj * 128);
        f32x4 gv[2][2];
#pragma unroll
        for (int bj = 0; bj < 2; ++bj)
#pragma unroll
            for (int n = 0; n < 2; ++n) gv[bj][n] = *(const f32x4*)(gpost + col0 + bj * 128 + 4 * n);
#pragma unroll
        for (int ai = 0; ai < 2; ++ai)
#pragma unroll
            for (int m = 0; m < 4; ++m) { float ss = 0.f;
#pragma unroll
                for (int bj = 0; bj < 2; ++bj)
#pragma unroll
                    for (int n = 0; n < 2; ++n) { const f32x4 v = acc[ai][bj][m][n]; ss += (v[0] * v[0] + v[1] * v[1]) + (v[2] * v[2] + v[3] * v[3]); }
                ss = sum_rows4(ss);
                P[(rl0 + ai * 128 + m * 16) * 4 + wc] = ss; }
        asm volatile("s_waitcnt lgkmcnt(0)" ::: "memory"); __builtin_amdgcn_s_barrier(); asm volatile("" ::: "memory");
        if (tid < 256) {
            const f32x4 p = *(const LAS f32x4*)(P + tid * 4);
            unsigned long long* sl = xb + (rowbase + tid) * 4;
            __hip_atomic_store(sl + u.pn, ((unsigned long long)tag << 32) | (unsigned long long)__float_as_uint((p[0] + p[1]) + (p[2] + p[3])), __ATOMIC_RELAXED, __HIP_MEMORY_SCOPE_AGENT);
            float t = 0.f; unsigned sp = 0;
            for (;;) { bool ok = true; t = 0.f;
#pragma unroll
                for (int k = 0; k < 4; ++k) { const unsigned long long w = __hip_atomic_load(sl + k, __ATOMIC_RELAXED, __HIP_MEMORY_SCOPE_AGENT); ok = ok && ((unsigned)(w >> 32) == tag); t += __uint_as_float((unsigned)w); }
                if (ok || ++sp > (1u << 20)) break;
                __builtin_amdgcn_s_sleep(1); }
            S[tid] = __builtin_amdgcn_rsqf(t * (1.0f / DM) + EPS); }
        asm volatile("s_waitcnt lgkmcnt(0)" ::: "memory"); __builtin_amdgcn_s_barrier(); asm volatile("" ::: "memory");
#define RESNORM_ROWGROUP(ai, m) do { const int rl = rl0 + (ai) * 128 + (m) * 16; const float rstd = S[rl]; float ss2 = 0.f; \
            _Pragma("unroll") for (int bj = 0; bj < 2; ++bj) { const v4u xw = xv[m][bj]; const f32x4 y0 = acc[ai][bj][m][0] * rstd * gv[bj][0], y1 = acc[ai][bj][m][1] * rstd * gv[bj][1]; \
                const f32x4 o0 = (f32x4){bf_lo(xw.x) + y0[0], bf_hi(xw.x) + y0[1], bf_lo(xw.y) + y0[2], bf_hi(xw.y) + y0[3]}; \
                const f32x4 o1 = (f32x4){bf_lo(xw.z) + y1[0], bf_hi(xw.z) + y1[1], bf_lo(xw.w) + y1[2], bf_hi(xw.w) + y1[3]}; \
                if (FINAL) { float* op = out + (rowbase + rl) * DM + col0 + bj * 128; *(f32x4*)op = o0; *(f32x4*)(op + 4) = o1; } \
                else { v4u w; w.x = cvt_pk_bf16(o0[0], o0[1]); w.y = cvt_pk_bf16(o0[2], o0[3]); w.z = cvt_pk_bf16(o1[0], o1[1]); w.w = cvt_pk_bf16(o1[2], o1[3]); \
                    _Pragma("unroll") for (int e = 0; e < 4; ++e) { const float a = bf_lo(w[e]), b = bf_hi(w[e]); ss2 += a * a + b * b; } \
                    *(v4u*)(X + (rowbase + rl) * DM + col0 + bj * 128) = w; } } \
            if (!FINAL) { ss2 = sum_rows4(ss2); Q[rl * 4 + wc] = ss2; } } while (0)
#pragma unroll
        for (int m = 0; m < 4; ++m) { RESNORM_ROWGROUP(0, m);
#pragma unroll
            for (int bj = 0; bj < 2; ++bj) xv[m][bj] = *(const v4u*)(X + (rowbase + rl0 + 128 + m * 16) * DM + col0 + bj * 128); }
#pragma unroll
        for (int m = 0; m < 4; ++m) RESNORM_ROWGROUP(1, m);
#undef RESNORM_ROWGROUP
        if (!FINAL) {
            asm volatile("s_waitcnt lgkmcnt(0)" ::: "memory"); __builtin_amdgcn_s_barrier(); asm volatile("" ::: "memory");
            if (tid < 256) { const f32x4 q = *(const LAS f32x4*)(Q + tid * 4); rssp[(rowbase + tid) * 4 + u.pn] = (q[0] + q[1]) + (q[2] + q[3]); }
        }
    }
};
struct EpiSwiGLU {
    static constexpr bool AFTER_DRAIN = false;
    __device__ __forceinline__ void begin(const pg8::Unit& cur, LAS unsigned char* lds, int tid) const { rowstat_begin(rss, cur, lds, tid); }
    bf16* ACT; const float* rss;
    __device__ __forceinline__ void operator()(const f32x4 (&acc)[2][2][4][2], const pg8::Unit& u, int wr, int wc, int fr, int fq, LAS unsigned char* lds, int wid, int lane, const pg8::Unit& nxt, bool has_next, int ui) const {
        const int row0 = u.pm * 256 + wr * 64 + fr, col = u.pn * 128 + wc * 32 + fq * 8, tid = wid * 64 + lane;
        const LAS float* R = (const LAS float*)(lds + RS_OFF) + (ui & 1) * 256;
        const bool pre = has_next && tid < 256; f32x4 qn = (f32x4){1.f, 1.f, 1.f, 1.f};
        if (pre) qn = *(const f32x4*)(rss + ((size_t)nxt.pm * 256 + tid) * 4);
#pragma unroll
        for (int ai = 0; ai < 2; ++ai) {
#pragma unroll
            for (int m = 0; m < 4; ++m) {
                const int row = row0 + ai * 128 + m * 16; const float r_ = R[wr * 64 + fr + ai * 128 + m * 16], kr = -1.4426950408889634f * r_, r2 = r_ * r_;
                float o[8];
#pragma unroll
                for (int e = 0; e < 8; ++e) { const float g_ = acc[ai][0][m][e >> 2][e & 3], u_ = acc[ai][1][m][e >> 2][e & 3];
                    o[e] = (g_ * u_) * (r2 * __builtin_amdgcn_rcpf(1.0f + __builtin_amdgcn_exp2f(kr * g_))); }
                v4u w; w.x = cvt_pk_bf16(o[0], o[1]); w.y = cvt_pk_bf16(o[2], o[3]); w.z = cvt_pk_bf16(o[4], o[5]); w.w = cvt_pk_bf16(o[6], o[7]);
                *(v4u*)(ACT + (size_t)row * FF + col) = w;
            }
            if (ai == 0) {
                __builtin_amdgcn_sched_barrier(0);
                float rn = rstd4(qn); asm volatile("" : "+v"(rn));
                if (pre) ((LAS float*)(lds + RS_OFF))[((ui + 1) & 1) * 256 + tid] = rn;
                __builtin_amdgcn_sched_barrier(0);
            }
        }
    }
};
struct EpiScan {
    static constexpr bool AFTER_DRAIN = true;
    __device__ __forceinline__ void begin(const pg8::Unit&, LAS unsigned char*, int) const {}
    bf16* A2; const f32x2* AT; int l;
    __device__ __forceinline__ void fused(const f32x4 (&acc)[2][2][4][2], const pg8::Unit& u, int wr, int wc, int fr, int fq, LAS unsigned char* lds, int wid, int lane) const {
        LAS float* T = (LAS float*)lds; constexpr int TP = 132;
        const int g = u.pm >> 3;
        const size_t row0 = (size_t)u.pm * 256;
#pragma unroll
        for (int bj = 0; bj < 2; ++bj) {
#pragma unroll
            for (int ai = 0; ai < 2; ++ai)
#pragma unroll
                for (int m = 0; m < 4; ++m) { LAS float* tp = T + (ai * 128 + wr * 64 + m * 16 + fr) * TP + wc * 32 + fq * 8;
                    *(LAS f32x4*)tp = acc[ai][bj][m][0]; *(LAS f32x4*)(tp + 4) = acc[ai][bj][m][1]; }
            asm volatile("s_waitcnt lgkmcnt(0)" ::: "memory"); __builtin_amdgcn_s_barrier(); asm volatile("" ::: "memory");
            if (wid == 0) {
                const int p = lane, d = bj;
                const f32x2 a = AT[((l * NG + g) * 2 + d) * NP + p];
                float xr = 0.f, xi = 0.f;
                for (int i0 = 0; i0 < 256; i0 += 8) {
                    float sr[8], si[8];
#pragma unroll
                    for (int i = 0; i < 8; ++i) { const int c = d == 0 ? i0 + i : 255 - (i0 + i); sr[i] = T[c * TP + p]; si[i] = T[c * TP + 64 + p]; }
#pragma unroll
                    for (int i = 0; i < 8; ++i) { const int c = d == 0 ? i0 + i : 255 - (i0 + i);
                        T[c * TP + p] = xr; T[c * TP + 64 + p] = xi;
                        const float nr = a.x * xr - a.y * xi + sr[i]; xi = a.x * xi + a.y * xr + si[i]; xr = nr; }
                }
            }
            asm volatile("s_waitcnt lgkmcnt(0)" ::: "memory"); __builtin_amdgcn_s_barrier(); asm volatile("" ::: "memory");
            {
                const int tid = wid * 64 + lane;
#pragma unroll
                for (int q = 0; q < 8; ++q) { const int e = q * 512 + tid, c = e >> 4, k8 = (e & 15) * 8;
                    const f32x4 v0 = *(const LAS f32x4*)(T + c * TP + k8), v1 = *(const LAS f32x4*)(T + c * TP + k8 + 4);
                    v4u w; w.x = cvt_pk_bf16(v0[0], v0[1]); w.y = cvt_pk_bf16(v0[2], v0[3]); w.z = cvt_pk_bf16(v1[0], v1[1]); w.w = cvt_pk_bf16(v1[2], v1[3]);
                    *(v4u*)(A2 + (row0 + c) * K2 + 512 + bj * 128 + k8) = w; }
            }
            asm volatile("s_waitcnt vmcnt(0) lgkmcnt(0)" ::: "memory"); __builtin_amdgcn_s_barrier(); asm volatile("" ::: "memory");
        }
    }
};
struct OrderG4 {
    int c;
    __device__ bool next(int i, pg8::Unit& u) const {
        if (i >= 22) return false;
        const int x = c & 7, j = c >> 3;
        if (i < 20) { u.pm = 32 * x + 8 * (i & 3) + (j & 7); u.pn = 4 * (i >> 2) + (j >> 3); }
        else        { u.pm = 32 * x + 16 * (i - 20) + (j & 15); u.pn = 20 + (j >> 4); }
        return true;
    }
};
struct OrderS1 { int vcu; __device__ bool next(int i, pg8::Unit& u) const { if (i > 0) return false; u.pm = 8 * (vcu & 31) + (vcu >> 5); u.pn = vcu & 31; return true; } };
struct OrderS2 { int vcu; __device__ bool next(int i, pg8::Unit& u) const { if (i > 1) return false; u.pm = 8 * (vcu & 31) + (vcu >> 5); u.pn = (vcu & 31) * 2 + i; return true; } };

__device__ __forceinline__ void transpose_item(const float* W, int K, int N, bf16* WT, int k0, int n0, int dst0, LAS float* scr, int lane, const float* gain = nullptr) {
    float tv[32];
#pragma unroll
    for (int i = 0; i < 32; ++i) { const int kk = 2 * i + (lane >> 5); tv[i] = W[(size_t)(k0 + kk) * N + n0 + (lane & 31)]; }
    if (gain) {
#pragma unroll
        for (int i = 0; i < 32; ++i) tv[i] *= gain[k0 + 2 * i + (lane >> 5)];
    }
#pragma unroll
    for (int i = 0; i < 32; ++i) { const int kk = 2 * i + (lane >> 5); scr[kk * 33 + (lane & 31)] = tv[i]; }
    asm volatile("s_waitcnt lgkmcnt(0)" ::: "memory");
    const int c = lane & 7;
#pragma unroll
    for (int j = 0; j < 4; ++j) { const int n = (lane >> 3) + 8 * j; const LAS float* s = scr + (8 * c) * 33 + n;
        v4u o; o.x = pk2(s[0 * 33], s[1 * 33]); o.y = pk2(s[2 * 33], s[3 * 33]); o.z = pk2(s[4 * 33], s[5 * 33]); o.w = pk2(s[6 * 33], s[7 * 33]);
        *(v4u*)(WT + (size_t)(dst0 + n) * K + k0 + 8 * c) = o; }
    asm volatile("s_waitcnt lgkmcnt(0)" ::: "memory");
}
__device__ __forceinline__ int glu_row(int j) { return 256 * (j >> 7) + (j & 127); }

__device__ __forceinline__ double exp_d(double x) {
    const double k = rint(x * 1.4426950408889634); double r = fma(-k, 0.6931471805599453, x); r = fma(-k, 2.3190468138462996e-17, r);
    double s = 1.0, term = 1.0;
#pragma unroll
    for (int i = 1; i <= 14; ++i) { term *= r * (1.0 / i); s += term; }
    const long long e = (long long)k + 1023; return s * __longlong_as_double(e << 52);
}
__device__ __forceinline__ void sincos_d(double th, double& sn, double& cs) {
    const double n = rint(th * 0.15915494309189535); double r = fma(-n, 6.283185307179586, th); r = fma(-n, 2.4492935982947064e-16, r);
    const double r2 = r * r; double ts = r, tc = 1.0; sn = r; cs = 1.0;
#pragma unroll
    for (int i = 1; i <= 15; ++i) { tc *= -r2 * (1.0 / ((2.0 * i - 1.0) * (2.0 * i))); cs += tc; ts *= -r2 * (1.0 / ((2.0 * i) * (2.0 * i + 1.0))); sn += ts; }
}

__device__ __forceinline__ void s5_build(const Frame& F, const float* const* in, unsigned char* ws, int l, int g) {
    LAS f32x2* pw = (LAS f32x2*)F.lds;
    LAS f32x2* Bb = (LAS f32x2*)(F.lds + 33792);
    LAS f32x2* Cc = (LAS f32x2*)(F.lds + 33792 + 16384);
    LAS float* Kt = (LAS float*)(F.lds + 33792 + 32768);
    int tid_ = F.tid; asm volatile("" : "+v"(tid_));
    const int tid = tid_;
    const float* a_re = in[8]; const float* a_im = in[9]; const float* log_dt = in[10]; const float* b_re = in[11]; const float* b_im = in[12];
    const float* c_re = in[13]; const float* c_im = in[14]; const float* dsk = in[15];
    if (tid < 128) {
        const int d = tid >> 6, p = tid & 63, ld = (l * 2 + d) * NG + g;
        const double are = a_re[ld * NP + p], aim = a_im[ld * NP + p], dt = exp_d((double)log_dt[ld]);
        double sn, cs; sincos_d(aim * dt, sn, cs); const double mg = exp_d(are * dt), abr = mg * cs, abi = mg * sn;
        double cr = 1.0, ci = 0.0;
        for (int k = 0; k <= TC; ++k) { pw[(d * 64 + p) * 33 + k] = (f32x2){(float)cr, (float)ci}; const double nr = cr * abr - ci * abi; ci = cr * abi + ci * abr; cr = nr; }
        {
            const f32x2 w = pw[(d * 64 + p) * 33 + TC]; ((f32x2*)(ws + WS_AT))[((l * NG + g) * 2 + d) * NP + p] = w;
        }
        const double nr = abr - 1.0, ni = abi, den = are * are + aim * aim, qr = (nr * are + ni * aim) / den, qi = (ni * are - nr * aim) / den;
#pragma unroll 4
        for (int h = 0; h < 16; ++h) { const double br = b_re[(ld * NP + p) * 16 + h], bi = b_im[(ld * NP + p) * 16 + h]; Bb[(d * 64 + p) * 16 + h] = (f32x2){(float)(qr * br - qi * bi), (float)(qr * bi + qi * br)}; }
    }
    for (int e = tid; e < 2048; e += NTHR) { const int d = e >> 10, h = (e >> 6) & 15, p = e & 63, idx = (((l * 2 + d) * NG + g) * 16 + h) * NP + p; Cc[e] = (f32x2){c_re[idx], c_im[idx]}; }
    __syncthreads();
    {
        const int d = tid >> 8, h = (tid >> 4) & 15, hp = tid & 15;
        float acc[TC];
#pragma unroll
        for (int k = 0; k < TC; ++k) acc[k] = 0.f;
        for (int p = 0; p < NP; ++p) {
            const f32x2 c = Cc[(d * 16 + h) * 64 + p], b = Bb[(d * 64 + p) * 16 + hp];
            const float cbr = c.x * b.x - c.y * b.y, cbi = c.x * b.y + c.y * b.x;
#pragma unroll
            for (int k = 0; k < TC; ++k) { const f32x2 w = pw[(d * 64 + p) * 33 + k]; acc[k] += cbr * w.x - cbi * w.y; }
        }
#pragma unroll
        for (int k = 0; k < TC; ++k) Kt[((d * TC + k) * 16 + h) * 16 + hp] = acc[k];
    }
    __syncthreads();
    bf16* B2 = (bf16*)(ws + WS_S5 + (size_t)l * S5_STRIDE + OFF_B2) + (size_t)g * 512 * K2;
    bf16* BS = (bf16*)(ws + WS_S5 + (size_t)l * S5_STRIDE + OFF_BS) + (size_t)g * 256 * 512;
    for (int q = tid; q < 512 * 64; q += NTHR) {
        const int n = q >> 6, kc = q & 63, t = n >> 4, h = n & 15, s = kc >> 1, h0 = (kc & 1) * 8;
        float v[8];
        const int d = (t >= s) ? 0 : 1, lag = (t >= s) ? (t - s) : (s - t);
        const LAS float* kp = Kt + ((d * TC + lag) * 16 + h) * 16 + h0;
#pragma unroll
        for (int e = 0; e < 8; ++e) v[e] = kp[e];
        if (t == s) { const LAS float* k1 = Kt + ((1 * TC + 0) * 16 + h) * 16 + h0; const float dv = dsk[l * SW + g * 16 + h];
#pragma unroll
            for (int e = 0; e < 8; ++e) v[e] += k1[e] + ((h0 + e == h) ? dv : 0.f); }
        v4u o; o.x = pk2(v[0], v[1]); o.y = pk2(v[2], v[3]); o.z = pk2(v[4], v[5]); o.w = pk2(v[6], v[7]);
        *(v4u*)(B2 + (size_t)n * K2 + kc * 8) = o;
    }
    for (int q = tid; q < 512 * 32; q += NTHR) {
        const int n = q >> 5, jc = q & 31, t = n >> 4, h = n & 15, j0 = jc * 8, sec = j0 >> 6, p0 = j0 & 63, d = sec >> 1, kk = d == 0 ? t + 1 : TC - t;
        float v[8];
#pragma unroll
        for (int e = 0; e < 8; ++e) { const f32x2 c = Cc[(d * 16 + h) * 64 + p0 + e], w = pw[(d * 64 + p0 + e) * 33 + kk]; v[e] = (sec & 1) ? -(c.x * w.y + c.y * w.x) : (c.x * w.x - c.y * w.y); }
        v4u o; o.x = pk2(v[0], v[1]); o.y = pk2(v[2], v[3]); o.z = pk2(v[4], v[5]); o.w = pk2(v[6], v[7]);
        *(v4u*)(B2 + (size_t)n * K2 + 512 + j0) = o;
    }
    for (int q = tid; q < 256 * 64; q += NTHR) {
        const int j = q >> 6, kc = q & 63, s = kc >> 1, h0 = (kc & 1) * 8, sec = j >> 6, p = j & 63, d = sec >> 1, kk = d == 0 ? TC - 1 - s : s;
        const f32x2 w = pw[(d * 64 + p) * 33 + kk];
        float v[8];
#pragma unroll
        for (int e = 0; e < 8; ++e) { const f32x2 b = Bb[(d * 64 + p) * 16 + h0 + e]; v[e] = (sec & 1) ? (w.x * b.y + w.y * b.x) : (w.x * b.x - w.y * b.y); }
        v4u o; o.x = pk2(v[0], v[1]); o.y = pk2(v[2], v[3]); o.z = pk2(v[4], v[5]); o.w = pk2(v[6], v[7]);
        *(v4u*)(BS + (size_t)j * 512 + kc * 8) = o;
    }
    __syncthreads();
}

template <int MODE>
__device__ __forceinline__ void e_phase(const Frame& F, const float* xin, bf16* X, const bf16* y, const float* rowpart, const float* gpost, float* rss, float* out) {
    int lane_ = F.lane; asm volatile("" : "+v"(lane_));
    constexpr int ER = 4;
    const int gw = (MODE == 0 ? F.vcu - DEPTH * NG : F.vcu) * NWAVES + F.wave, NGW = (MODE == 0 ? F.G - DEPTH * NG : F.G) * NWAVES, lane = lane_;
    f32x4 gp[2][2];
#pragma unroll
    for (int j = 0; j < 2; ++j)
#pragma unroll
        for (int n = 0; n < 2; ++n) gp[j][n] = MODE ? *(const f32x4*)(gpost + 8 * lane + 512 * j + 4 * n) : (f32x4){0.f, 0.f, 0.f, 0.f};
    for (int m0 = (gw < 0 ? M : gw * ER); m0 < M; m0 += NGW * ER) {
        v4u xv[ER][2], yv[ER][2]; f32x4 xf[ER][2][2]; float rp[ER];
#pragma unroll
        for (int r = 0; r < ER; ++r) { const size_t off = (size_t)(m0 + r) * DM + 8 * lane;
            if (MODE == 0) {
#pragma unroll
                for (int j = 0; j < 2; ++j) { xf[r][j][0] = *(const f32x4*)(xin + off + 512 * j); xf[r][j][1] = *(const f32x4*)(xin + off + 512 * j + 4); }
            } else {
#pragma unroll
                for (int j = 0; j < 2; ++j) { xv[r][j] = *(const v4u*)(X + off + 512 * j); yv[r][j] = *(const v4u*)(y + off + 512 * j); }
                rp[r] = rowpart[(size_t)(m0 + r) * 16 + (lane & 15)];
            } }
#pragma unroll
        for (int r = 0; r < ER; ++r) { const size_t off = (size_t)(m0 + r) * DM + 8 * lane;
            float v[2][8];
            if (MODE == 0) {
#pragma unroll
                for (int j = 0; j < 2; ++j)
#pragma unroll
                    for (int e = 0; e < 4; ++e) { v[j][e] = xf[r][j][0][e]; v[j][4 + e] = xf[r][j][1][e]; }
            } else {
                float q = rp[r]; q += __shfl_xor(q, 1); q += __shfl_xor(q, 2); q += __shfl_xor(q, 4); q += __shfl_xor(q, 8);
                const float rstd = 1.0f / sqrtf(q * (1.0f / DM) + EPS);
#pragma unroll
                for (int j = 0; j < 2; ++j)
#pragma unroll
                    for (int e = 0; e < 4; ++e) {
                        v[j][2 * e] = bf_lo(xv[r][j][e]) + bf_lo(yv[r][j][e]) * rstd * gp[j][e >> 1][(2 * e) & 3];
                        v[j][2 * e + 1] = bf_hi(xv[r][j][e]) + bf_hi(yv[r][j][e]) * rstd * gp[j][e >> 1][(2 * e + 1) & 3];
                    }
            }
            if (MODE == 2) {
#pragma unroll
                for (int j = 0; j < 2; ++j) { *(f32x4*)(out + off + 512 * j) = (f32x4){v[j][0], v[j][1], v[j][2], v[j][3]}; *(f32x4*)(out + off + 512 * j + 4) = (f32x4){v[j][4], v[j][5], v[j][6], v[j][7]}; }
            } else {
                float s = 0.f;
#pragma unroll
                for (int j = 0; j < 2; ++j) {
                    v4u o; o.x = cvt_pk_bf16(v[j][0], v[j][1]); o.y = cvt_pk_bf16(v[j][2], v[j][3]); o.z = cvt_pk_bf16(v[j][4], v[j][5]); o.w = cvt_pk_bf16(v[j][6], v[j][7]);
#pragma unroll
                    for (int e = 0; e < 4; ++e) { const float a = bf_lo(o[e]), b = bf_hi(o[e]); s += a * a + b * b; }
                    *(v4u*)(X + off + 512 * j) = o;
                }
                s = wave_sum_dpp(s);
                if (lane == 0) *(f32x4*)(rss + (size_t)(m0 + r) * 4) = (f32x4){s, 0.f, 0.f, 0.f};
            }
        }
    }
}

__device__ __forceinline__ void p0_prologue(const Frame& F, const float* const* in, unsigned char* ws) {
    LAS float* scr = (LAS float*)(F.lds + F.wave * 16384);
    const int NS5 = DEPTH * NG;
    const int gw = (F.vcu - NS5) * NWAVES + F.wave, NGW = (F.G - NS5) * NWAVES;
    constexpr int I_IN = 16 * 48, I_GLU = 8 * 16, I_OUT = 16 * 32, I_GT = 16 * 88, I_DN = 44 * 32, I_L = I_IN + I_GLU + I_OUT + 2 * I_GT + I_DN;
    if (F.vcu >= NS5)
    for (int it = gw; it < DEPTH * I_L; it += NGW) {
        const int l = it / I_L; int r = it % I_L;
        unsigned char* wl = ws + WS_WL + (size_t)l * WL_STRIDE;
        if (r < I_IN) { const int kb = r / 48, nb = r % 48, n0 = nb * 32; const int dst = n0 < 512 ? glu_row(n0) : (n0 < 1024 ? glu_row(n0 - 512) + 128 : n0);
            transpose_item(in[3] + (size_t)l * DM * INC, DM, INC, (bf16*)(wl + OFF_WIN), kb * 64, n0, dst, scr, F.lane, in[1] + l * DM); continue; } r -= I_IN;
        if (r < I_GLU) { const int kb = r / 16, nb = r % 16; transpose_item(in[16] + (size_t)l * SW * SW, SW, SW, (bf16*)(wl + OFF_GLUW), kb * 64, nb * 32, nb * 32, scr, F.lane); continue; } r -= I_GLU;
        if (r < I_OUT) { const int kb = r / 32, nb = r % 32; transpose_item(in[18] + (size_t)l * DM * DM, DM, DM, (bf16*)(wl + OFF_WOUT), kb * 64, nb * 32, nb * 32, scr, F.lane); continue; } r -= I_OUT;
        if (r < I_GT) { const int kb = r / 88, nb = r % 88; transpose_item(in[21] + (size_t)l * DM * FF, DM, FF, (bf16*)(wl + OFF_WGU), kb * 64, nb * 32, glu_row(nb * 32), scr, F.lane, in[19] + l * DM); continue; } r -= I_GT;
        if (r < I_GT) { const int kb = r / 88, nb = r % 88; transpose_item(in[22] + (size_t)l * DM * FF, DM, FF, (bf16*)(wl + OFF_WGU), kb * 64, nb * 32, glu_row(nb * 32) + 128, scr, F.lane, in[19] + l * DM); continue; } r -= I_GT;
        { const int kb = r / 32, nb = r % 32; transpose_item(in[23] + (size_t)l * FF * DM, FF, DM, (bf16*)(wl + OFF_WDN), kb * 64, nb * 32, nb * 32, scr, F.lane); }
    }
    __syncthreads();
    if (F.vcu < DEPTH * NG) s5_build(F, in, ws, F.vcu / NG, F.vcu % NG);
    e_phase<0>(F, in[0], (bf16*)(ws + WS_H), nullptr, nullptr, nullptr, (float*)(ws + WS_RSS), nullptr);
}

__device__ __forceinline__ void conv_phase(const Frame& F, const bf16* CG, bf16* CAT, const float* dw_w, const float* dw_b, const float* ln_g, const float* ln_b) {
    LAS unsigned* it = (LAS unsigned*)F.lds;
    LAS float* yt = (LAS float*)(F.lds + 63488);
    int tid_ = F.tid; asm volatile("" : "+v"(tid_));
    const int tid = tid_, cp = tid & 255, th = tid >> 8, lane = tid & 63, wave = tid >> 6;
    f32x2 w[KC];
#pragma unroll
    for (int j = 0; j < KC; ++j) w[j] = *(const f32x2*)(dw_w + j * CW + 2 * cp);
    const f32x2 bias = *(const f32x2*)(dw_b + 2 * cp);
    f32x4 lg[2], lb[2];
#pragma unroll
    for (int j = 0; j < 2; ++j) { lg[j] = *(const f32x4*)(ln_g + 8 * lane + 4 * j); lb[j] = *(const f32x4*)(ln_b + 8 * lane + 4 * j); }
    v4u pf[8];
#define CONV_LOAD(uu) do { const int b_ = (uu) >> 8, t0_ = ((uu) & 255) * 32; _Pragma("unroll") for (int i = 0; i < 8; ++i) { const int idx = tid + i * 512, row = idx >> 6, c16 = idx & 63, tok = t0_ - 15 + row; \
        pf[i] = (v4u){0u, 0u, 0u, 0u}; if (idx < 62 * 64 && tok >= 0 && tok < SEQ) pf[i] = *(const v4u*)(CG + ((size_t)(b_ * SEQ + tok) * CW + c16 * 8)); } } while (0)
    const int ub = (F.vcu >> 5) * 256 + (F.vcu & 31);
    CONV_LOAD(ub);
    for (int kk = 0; kk < 8; ++kk) { const int u = ub + 32 * kk;
        const int b = u >> 8, t0 = (u & 255) * 32;
#pragma unroll
        for (int i = 0; i < 8; ++i) { const int idx = tid + i * 512; if (idx < 62 * 64) *(LAS v4u*)(it + idx * 4) = pf[i]; }
        __syncthreads();
        if (kk + 1 < 8) CONV_LOAD(u + 32);
        {
            f32x2 a[16];
#pragma unroll
            for (int tt = 0; tt < 16; ++tt) a[tt] = bias;
            unsigned xin[46];
#pragma unroll
            for (int r = 0; r < 46; ++r) xin[r] = it[(th * 16 + r) * 256 + cp];
#pragma unroll
            for (int r = 0; r < 46; ++r) {
                const unsigned v = xin[r]; const f32x2 x = (f32x2){bf_lo(v), bf_hi(v)};
#pragma unroll
                for (int tt = 0; tt < 16; ++tt) { const int j = r - tt; if (j >= 0 && j < KC) a[tt] += w[j] * x; }
            }
#pragma unroll
            for (int tt = 0; tt < 16; ++tt) *(LAS f32x2*)(yt + (th * 16 + tt) * 512 + 2 * cp) = a[tt];
        }
        __syncthreads();
        {
            f32x4 v0[4], v1[4]; float s1[4], s2[4];
#pragma unroll
            for (int q = 0; q < 4; ++q) { const int t = wave * 4 + q; v0[q] = *(const LAS f32x4*)(yt + t * 512 + 8 * lane); v1[q] = *(const LAS f32x4*)(yt + t * 512 + 8 * lane + 4); }
#pragma unroll
            for (int q = 0; q < 4; ++q) {
                s1[q] = (v0[q][0] + v0[q][1]) + (v0[q][2] + v0[q][3]) + (v1[q][0] + v1[q][1]) + (v1[q][2] + v1[q][3]);
                s2[q] = (v0[q][0] * v0[q][0] + v0[q][1] * v0[q][1]) + (v0[q][2] * v0[q][2] + v0[q][3] * v0[q][3]) + (v1[q][0] * v1[q][0] + v1[q][1] * v1[q][1]) + (v1[q][2] * v1[q][2] + v1[q][3] * v1[q][3]);
            }
#pragma unroll
            for (int q = 0; q < 4; ++q) { s1[q] = wave_sum_dpp(s1[q]); s2[q] = wave_sum_dpp(s2[q]); }
#pragma unroll
            for (int q = 0; q < 4; ++q) {
                const int t = wave * 4 + q;
                const float mu = s1[q] * (1.0f / CW), var = fmaxf(s2[q] * (1.0f / CW) - mu * mu, 0.f), rs = __builtin_amdgcn_rsqf(var + EPS);
                float o[8];
#pragma unroll
                for (int e = 0; e < 4; ++e) { const float y0 = (v0[q][e] - mu) * rs * lg[0][e] + lb[0][e], y1 = (v1[q][e] - mu) * rs * lg[1][e] + lb[1][e]; o[e] = y0 * sigmoid_f(y0); o[4 + e] = y1 * sigmoid_f(y1); }
                v4u wv; wv.x = cvt_pk_bf16(o[0], o[1]); wv.y = cvt_pk_bf16(o[2], o[3]); wv.z = cvt_pk_bf16(o[4], o[5]); wv.w = cvt_pk_bf16(o[6], o[7]);
                *(v4u*)(CAT + ((size_t)(b * SEQ + t0 + t) * DM + 8 * lane)) = wv;
            }
        }
    }
#undef CONV_LOAD
    __syncthreads();
}

__device__ __forceinline__ void scan_phase(const Frame& F, const float* S, bf16* A2, const f32x2* AT, int l) {
    int tid_ = F.tid; asm volatile("" : "+v"(tid_));
    if (tid_ >= 128) return;
    for (int blk = F.vcu; blk < NG * NB; blk += F.G) {
        const int g = blk >> 3, b = blk & 7, d = tid_ >> 6, p = tid_ & 63;
        const f32x2 a = AT[((l * NG + g) * 2 + d) * NP + p];
        const size_t row0 = (size_t)g * RPG + b * 256;
        float xr = 0.f, xi = 0.f;
        for (int c0 = 0; c0 < 256; c0 += 16) {
            float sr[16], si[16];
#pragma unroll
            for (int i = 0; i < 16; ++i) { const int c = d == 0 ? c0 + i : 255 - (c0 + i); const float* sp = S + (row0 + c) * 256 + d * 128 + p; sr[i] = sp[0]; si[i] = sp[64]; }
#pragma unroll
            for (int i = 0; i < 16; ++i) { const int c = d == 0 ? c0 + i : 255 - (c0 + i); bf16* cp = A2 + (row0 + c) * K2 + 512 + d * 128 + p;
                cp[0] = (bf16)f2bf(xr); cp[64] = (bf16)f2bf(xi);
                const float nr = a.x * xr - a.y * xi + sr[i]; xi = a.x * xi + a.y * xr + si[i]; xr = nr; }
        }
    }
}

struct Args { const float* in[24]; float* out; unsigned char* ws; int ph_lo, ph_hi; };
constexpr int PH_PER_LAYER = 10, N_PHASES = 1 + DEPTH * PH_PER_LAYER;

__global__ void __launch_bounds__(NTHR, 2) fwd_kernel(Args args) {
    extern __shared__ __attribute__((aligned(16))) unsigned char lds_raw[];
    Frame F;
    F.lds = (LAS unsigned char*)lds_raw;
    F.tid = threadIdx.x; F.lane = F.tid & 63; F.wave = __builtin_amdgcn_readfirstlane(F.tid >> 6);
    F.G = gridDim.x; { const int bx = blockIdx.x; F.vcu = (F.G % 8 == 0) ? (bx % 8) * (F.G / 8) + bx / 8 : bx; }
    unsigned char* ws = args.ws;
    const float* const* in = args.in;
    const int lo = args.ph_lo, hi = args.ph_hi;
    cg::grid_group grid = cg::this_grid();
    volatile LAS unsigned* bst = (volatile LAS unsigned*)(F.lds + LDS_BYTES - 64);
    if (F.tid < 16) bst[F.tid] = 0u;
    __syncthreads();
    (void)xcd_barrier_post((unsigned*)(ws + WS_BAR), bst, gridDim.x);
    (void)xcd_barrier_post((unsigned*)(ws + WS_BAR) + (1 + (blockIdx.x & 7)) * BAR_REGION_WORDS, bst + 2, gridDim.x >> 3);
    (void)xcd_barrier_post((unsigned*)(ws + WS_BAR) + (9 + (blockIdx.x & 7) * 8 + ((blockIdx.x >> 3) & 7)) * BAR_REGION_WORDS, bst + 4, gridDim.x >> 6);
#define GROUP_BAR() do { XcdBarrier b_; b_.bar = (unsigned*)(args.ws + WS_BAR) + (9 + (blockIdx.x & 7) * 8 + ((blockIdx.x >> 3) & 7)) * BAR_REGION_WORDS; b_.x = xb_xcc_id(); b_.st = (volatile LAS unsigned*)(F.lds + LDS_BYTES - 64) + 4; b_.G = gridDim.x >> 6; xcd_barrier(b_); } while (0)
#define GRID_BAR() do { XcdBarrier b_; b_.bar = (unsigned*)(args.ws + WS_BAR); b_.x = xb_xcc_id(); b_.st = (volatile LAS unsigned*)(F.lds + LDS_BYTES - 64); b_.G = gridDim.x; xcd_barrier(b_); } while (0)
#define CLASS_BAR() do { XcdBarrier b_; b_.bar = (unsigned*)(args.ws + WS_BAR) + (1 + (blockIdx.x & 7)) * BAR_REGION_WORDS; b_.x = xb_xcc_id(); b_.st = (volatile LAS unsigned*)(F.lds + LDS_BYTES - 64) + 2; b_.G = gridDim.x >> 3; xcd_barrier(b_); } while (0)
    if (args.ph_lo < 0) grid.sync();
#define IN(k) (lo <= (k) && (k) < hi)
#ifndef REPMASK
#define REPMASK 0u
#endif
#define REPS(j) (((REPMASK >> (j)) & 1u) ? 2 : 1)
#define SEAM(k) do { if (IN(k) && IN((k) + 1)) { if ((k) == 0) GRID_BAR(); else CLASS_BAR(); } } while (0)
#define SEAM_GROUP(k) do { if (IN(k) && IN((k) + 1)) { GROUP_BAR(); } } while (0)

    for (int rep = 0; rep < REPS(0); ++rep) { if (rep) GRID_BAR(); if (IN(0)) { p0_prologue(F, in, ws); } } SEAM(0);

    bf16* const H = (bf16*)(ws + WS_H); float* const RSS = (float*)(ws + WS_RSS);
    bf16* const ACT = (bf16*)(ws + WS_BIG);
    bf16* const CGb = (bf16*)(ws + WS_CG); bf16* const Zb = (bf16*)(ws + WS_Z); bf16* const A2 = (bf16*)(ws + WS_A2); bf16* const CAT = (bf16*)(ws + WS_CAT);

    for (int l = 0; l < DEPTH; ++l) {
        const int pb = 1 + l * PH_PER_LAYER;
        const unsigned char* wl = ws + WS_WL + (size_t)l * WL_STRIDE;
        const unsigned char* s5 = ws + WS_S5 + (size_t)l * S5_STRIDE;
        for (int rep = 0; rep < ((0 != 6 || l == 0) ? REPS(1) : 1); ++rep) { if (rep) GRID_BAR();
        if (IN(pb + 0)) {
            pg8::Gemm g{H, (const bf16*)(wl + OFF_WIN), DM, DM, DM}; pg8::StaticOrder S; S.init(M, INC, F.G, (int)blockIdx.x);
            EpiProj E{CGb, A2, RSS}; pg8::gemm_phase(F.lds, g, S, E);
        } } SEAM(pb + 0);
        { for (int step = 0; step < 2; ++step) { if (((step ^ (int)blockIdx.x) & 1) == 0) { conv_phase(F, CGb, CAT, in[4] + l * KC * CW, in[5] + l * CW, in[6] + l * CW, in[7] + l * CW); } else
        if (IN(pb + 1)) {
            pg8::Gemm g{A2, (const bf16*)(s5 + OFF_BS), K2, 512, 512}; OrderS1 S{F.vcu}; EpiScan E{A2, (const f32x2*)(ws + WS_AT), l}; pg8::gemm_phase(F.lds, g, S, E);
            __builtin_amdgcn_fence(__ATOMIC_ACQUIRE, "agent"); asm volatile("s_waitcnt vmcnt(0)" ::: "memory"); __syncthreads();
            pg8::Gemm g2{A2, (const bf16*)(s5 + OFF_B2), K2, K2, K2}; OrderS2 S2{F.vcu}; EpiS5 E2{Zb}; pg8::gemm_phase(F.lds, g2, S2, E2);
        } } } SEAM(pb + 1);
        for (int rep = 0; rep < ((2 != 6 || l == 0) ? REPS(3) : 1); ++rep) { if (rep) GRID_BAR();
        if (IN(pb + 2)) { } }
        for (int rep = 0; rep < ((3 != 6 || l == 0) ? REPS(4) : 1); ++rep) { if (rep) GRID_BAR();
        if (IN(pb + 3)) {
        } }
        for (int rep = 0; rep < ((4 != 6 || l == 0) ? REPS(5) : 1); ++rep) { if (rep) GRID_BAR();
        if (IN(pb + 4)) {
            pg8::Gemm g{Zb, (const bf16*)(wl + OFF_GLUW), SW, SW, SW}; pg8::StaticOrder S; S.init(M, SW, F.G, (int)blockIdx.x);
            EpiGate E{Zb, CAT, in[17] + l * SW}; pg8::gemm_phase(F.lds, g, S, E);
        } } SEAM_GROUP(pb + 4);
        for (int rep = 0; rep < 1; ++rep) { if (rep) GRID_BAR();
        if (IN(pb + 5)) {
            pg8::Gemm g{CAT, (const bf16*)(wl + OFF_WOUT), DM, DM, DM}; pg8::StaticOrder S; S.init(M, DM, F.G, (int)blockIdx.x);
            EpiResNorm<false> E{H, in[2] + l * DM, (unsigned long long*)(ws + WS_XB), (unsigned)(2 * l + 1), RSS, nullptr}; pg8::gemm_phase(F.lds, g, S, E);
        } } SEAM_GROUP(pb + 5);
        for (int rep = 0; rep < 1; ++rep) { if (rep) GRID_BAR();
        if (IN(pb + 6)) { } }
        for (int rep = 0; rep < ((7 != 6 || l == 0) ? REPS(8) : 1); ++rep) { if (rep) GRID_BAR();
        if (IN(pb + 7)) {
            pg8::Gemm g{H, (const bf16*)(wl + OFF_WGU), DM, DM, DM}; OrderG4 S{(int)blockIdx.x};
            EpiSwiGLU E{ACT, RSS}; pg8::gemm_phase(F.lds, g, S, E);
        } } SEAM_GROUP(pb + 7);
        for (int rep = 0; rep < 1; ++rep) { if (rep) GRID_BAR();
        if (IN(pb + 8)) {
            pg8::Gemm g{ACT, (const bf16*)(wl + OFF_WDN), FF, FF, FF}; pg8::StaticOrder S; S.init(M, DM, F.G, (int)blockIdx.x);
            const unsigned cn = (unsigned)(2 * l + 2);
            if (l + 1 < DEPTH) { EpiResNorm<false> E{H, in[20] + l * DM, (unsigned long long*)(ws + WS_XB), cn, RSS, nullptr}; pg8::gemm_phase(F.lds, g, S, E); }
            else { EpiResNorm<true> E{H, in[20] + l * DM, (unsigned long long*)(ws + WS_XB), cn, nullptr, args.out}; pg8::gemm_phase(F.lds, g, S, E); }
        } } if (l + 1 < DEPTH) SEAM_GROUP(pb + 8);
        for (int rep = 0; rep < ((9 != 6 || l == 0) ? REPS(10) : 1); ++rep) { if (rep) GRID_BAR();
        if (IN(pb + 9)) { } }
    }
#undef IN
#undef SEAM
}

#ifndef MK_PER_PHASE
#define MK_PER_PHASE 0
#endif
extern "C" void kernel_launch(void* const* d_in, const int* in_sizes, int n_in, void* d_out, int out_size, void* d_ws, size_t ws_size, hipStream_t stream) {
    static int grid = 0;
    if (grid == 0) {
        if (n_in != 24 || in_sizes[0] != M * DM || out_size != M * DM || ws_size < WS_END) { fprintf(stderr, "kernel_launch: unexpected shapes (n_in %d, in0 %d, out %d, ws %zu)\n", n_in, n_in > 0 ? in_sizes[0] : -1, out_size, ws_size); grid = -1; return; }
        int dev = 0, cus = 0, per_cu = 0;
        if (hipGetDevice(&dev) != hipSuccess || hipDeviceGetAttribute(&cus, hipDeviceAttributeMultiprocessorCount, dev) != hipSuccess) { grid = -1; return; }
        if (hipFuncSetAttribute((const void*)fwd_kernel, hipFuncAttributeMaxDynamicSharedMemorySize, LDS_BYTES) != hipSuccess) { fprintf(stderr, "kernel_launch: hipFuncSetAttribute failed\n"); grid = -1; return; }
        if (hipOccupancyMaxActiveBlocksPerMultiprocessor(&per_cu, (const void*)fwd_kernel, NTHR, LDS_BYTES) != hipSuccess || per_cu < 1) { fprintf(stderr, "kernel_launch: occupancy query says %d\n", per_cu); per_cu = 1; }
        (void)hipGetLastError();
        grid = cus;
        if (grid > 256) grid = 256;
    }
    if (grid < 0) return;
    if (hipMemsetAsync((char*)d_ws + WS_BAR, 0, BAR_BYTES, stream) != hipSuccess) { fprintf(stderr, "kernel_launch: memset of barrier words failed\n"); return; }
    Args a{};
    for (int i = 0; i < 24; ++i) a.in[i] = (const float*)d_in[i];
    a.out = (float*)d_out; a.ws = (unsigned char*)d_ws;
#if MK_PER_PHASE
    for (int ph = 0; ph < N_PHASES; ++ph) {
        a.ph_lo = ph; a.ph_hi = ph + 1;
        void* kargs[] = {&a};
        hipError_t e = hipLaunchCooperativeKernel((const void*)fwd_kernel, dim3(grid), dim3(NTHR), kargs, LDS_BYTES, stream);
        if (e != hipSuccess) { fprintf(stderr, "launch phase %d failed: %s\n", ph, hipGetErrorString(e)); break; }
    }
#else
    a.ph_lo = 0; a.ph_hi = N_PHASES;
    void* kargs[] = {&a};
    hipError_t e = hipLaunchCooperativeKernel((const void*)fwd_kernel, dim3(grid), dim3(NTHR), kargs, LDS_BYTES, stream);
    if (e != hipSuccess) fprintf(stderr, "cooperative launch failed: %s (grid %d)\n", hipGetErrorString(e), grid);
#endif
}
```

```cpp
#include <hip/hip_runtime.h>
#include <hip/hip_cooperative_groups.h>
#include <cstdio>
#include <cstdint>
namespace cg = cooperative_groups;

namespace pg8 {
#define PG8_LAS __attribute__((address_space(3)))
typedef unsigned short bf16_t;
typedef short bf16x8 __attribute__((ext_vector_type(8)));
typedef float f32x4 __attribute__((ext_vector_type(4)));
typedef unsigned u32x4 __attribute__((ext_vector_type(4)));
constexpr int BM = 256, BK = 64, HALF = 128, HTB = HALF * BK * 2, STAGE_BYTES = 8 * HTB, NXCD = 8, WGM = 8;

__host__ __device__ __forceinline__ int lds_byte(int r, int c) { const int st = (r >> 4) * 2 + (c >> 5), rr = r & 15, cc = c & 31, ob = rr * 64 + cc * 2; return st * 1024 + (ob ^ (((ob >> 9) & 1) << 5)); }
__host__ __device__ __forceinline__ void stage_rc(int b, int& R, int& C) { const int st = b / 1024, sb = b % 1024, swz = sb ^ (((sb >> 9) & 1) << 5); R = (st >> 1) * 16 + swz / 64; C = (st & 1) * 32 + (swz % 64) / 2; }
__host__ __device__ __forceinline__ int perm32(int rho) { const int n = rho >> 4, i = rho & 15; return 8 * (i >> 2) + 4 * n + (i & 3); }

struct Unit { int pm, pn; };
struct Gemm { const bf16_t* A; const bf16_t* Bt; int lda, ldb, K; };

struct StaticOrder {
    int nM, nN, nwg, G, c;
    __host__ __device__ void init(int M, int N, int G_, int c_) { nM = M / BM; nN = N / BM; nwg = nM * nN; G = G_; c = c_; }
    __host__ __device__ bool next(int i, Unit& u) const {
        const long L = (long)i * G + c; if (L >= nwg) return false;
        int wgid = (int)L; { const int q = nwg / NXCD, r = nwg % NXCD, xcd = wgid % NXCD, off = wgid / NXCD; wgid = (xcd < r ? xcd * (q + 1) : r * (q + 1) + (xcd - r) * q) + off; }
        const int nig = WGM * nN, gid = wgid / nig, fm = gid * WGM, gsz = (nM - fm) < WGM ? (nM - fm) : WGM;
        u.pm = fm + ((wgid % nig) % gsz); u.pn = (wgid % nig) / gsz; return true;
    }
};

__device__ __forceinline__ unsigned cvt_pk_bf16(float lo, float hi) { unsigned r; asm volatile("v_cvt_pk_bf16_f32 %0, %1, %2" : "=v"(r) : "v"(lo), "v"(hi)); return r; }

template <class Epi, class Sched>
__device__ __forceinline__ void gemm_phase(PG8_LAS unsigned char* lds, const Gemm g, const Sched& S, const Epi& E) {
    int tid_ = threadIdx.x; asm volatile("" : "+v"(tid_));
    const int tid = tid_, wid = __builtin_amdgcn_readfirstlane(tid >> 6), lane = tid & 63, wr = wid >> 2, wc = wid & 3, fr = lane & 15, fq = lane >> 4;
    const int K = g.K, nt = K / BK;
    unsigned voffA[2], voffB[2];
#pragma unroll
    for (int i = 0; i < 2; ++i) { int R, C; stage_rc(tid * 16 + i * 8192, R, C); const int Rb = (R & ~31) + perm32(R & 31);
        voffA[i] = (unsigned)(R * g.lda + C) * 2u; voffB[i] = (unsigned)(Rb * g.ldb + C) * 2u; }
    const size_t kstep = (size_t)(BK * 2);
    const size_t hstepA = (size_t)HALF * g.lda * 2, hstepB = (size_t)HALF * g.ldb * 2;
    const size_t tstepA = 2 * hstepA, tstepB = 2 * hstepB;
    const unsigned ldsw = (unsigned)wid * 1024u;
    const int aoff = lds_byte(wr * 64 + fr, fq * 8), boff = lds_byte(wc * 32 + fr, fq * 8);
#define PG8_SA(b, h) (((b) * 2 + (h)) * HTB)
#define PG8_SB(b, h) ((4 + (b) * 2 + (h)) * HTB)
#define PG8_STAGE(bufoff, gbase, voff) do { _Pragma("unroll") for (int _i = 0; _i < 2; ++_i) \
        __builtin_amdgcn_global_load_lds((const unsigned*)((const char*)(gbase) + (voff)[_i]), (PG8_LAS unsigned*)(lds + (bufoff) + ldsw + _i * 8192), 16, 0, 0); } while (0)
#define PG8_LDA(dst, b, h) do { _Pragma("unroll") for (int m = 0; m < 4; ++m) _Pragma("unroll") for (int k = 0; k < 2; ++k) dst[m][k] = *(const PG8_LAS bf16x8*)(lds + PG8_SA(b, h) + aoff + m * 2048 + k * 1024); } while (0)
#define PG8_LDB(dst, b, h) do { _Pragma("unroll") for (int n = 0; n < 2; ++n) _Pragma("unroll") for (int k = 0; k < 2; ++k) dst[n][k] = *(const PG8_LAS bf16x8*)(lds + PG8_SB(b, h) + boff + n * 2048 + k * 1024); } while (0)
#define PG8_MMA(ai, bj, At, Bt) do { __builtin_amdgcn_s_setprio(1); _Pragma("unroll") for (int m = 0; m < 4; ++m) _Pragma("unroll") for (int n = 0; n < 2; ++n) _Pragma("unroll") for (int k = 0; k < 2; ++k) \
        acc[ai][bj][m][n] = __builtin_amdgcn_mfma_f32_16x16x32_bf16(Bt[n][k], At[m][k], acc[ai][bj][m][n], 0, 0, 0); __builtin_amdgcn_s_setprio(0); } while (0)
#define PG8_WAIT_V(n) asm volatile("s_waitcnt vmcnt(" #n ")" ::: "memory")
#define PG8_WAIT_L(n) asm volatile("s_waitcnt lgkmcnt(" #n ")" ::: "memory")
#define PG8_BAR __builtin_amdgcn_s_barrier()
#define PG8_SCHED __builtin_amdgcn_sched_barrier(0)
    Unit cur, nxt; int ui = 0;
    if (!S.next(0, cur)) return;
    f32x4 acc[2][2][4][2];
#pragma unroll
    for (int a = 0; a < 2; ++a)
#pragma unroll
        for (int b = 0; b < 2; ++b)
#pragma unroll
            for (int m = 0; m < 4; ++m)
#pragma unroll
                for (int n = 0; n < 2; ++n) acc[a][b][m][n] = (f32x4){0.f, 0.f, 0.f, 0.f};
    bf16x8 At[4][2], B0[2][2], B1[2][2];
    const char* cA = (const char*)g.A + (size_t)cur.pm * tstepA; const char* cB = (const char*)g.Bt + (size_t)cur.pn * tstepB;
    E.begin(cur, lds, tid);
    PG8_STAGE(PG8_SB(0, 0), cB, voffB); PG8_STAGE(PG8_SB(0, 1), cB + hstepB, voffB); PG8_STAGE(PG8_SA(0, 0), cA, voffA); PG8_STAGE(PG8_SA(0, 1), cA + hstepA, voffA);
    if (wr == 1) PG8_BAR;
    PG8_WAIT_V(2); PG8_BAR;
    PG8_STAGE(PG8_SB(1, 0), cB + kstep, voffB); PG8_STAGE(PG8_SA(1, 0), cA + kstep, voffA); PG8_STAGE(PG8_SB(1, 1), cB + hstepB + kstep, voffB);
    PG8_WAIT_V(6); PG8_BAR;
    for (;;) {
        const bool has_next = S.next(ui + 1, nxt);
        const char* nA = has_next ? (const char*)g.A + (size_t)nxt.pm * tstepA : cA; const char* nB = has_next ? (const char*)g.Bt + (size_t)nxt.pn * tstepB : cB;
        for (int t = 0; t < nt; t += 2) {
            const bool last = (t == nt - 2);
            const char* a1 = cA + (size_t)(t + 1) * kstep;
            const char* a2 = last ? nA : cA + (size_t)(t + 2) * kstep; const char* b2 = last ? nB : cB + (size_t)(t + 2) * kstep;
            const char* a3 = a2 + kstep; const char* b3 = b2 + kstep;
            PG8_LDB(B0, 0, 0); PG8_LDB(B1, 0, 1); PG8_SCHED; PG8_LDA(At, 0, 0); PG8_STAGE(PG8_SA(1, 1), a1 + hstepA, voffA);
            PG8_WAIT_V(8); PG8_WAIT_L(0); PG8_BAR; PG8_MMA(0, 0, At, B0); PG8_MMA(0, 1, At, B1); PG8_BAR; PG8_SCHED;
            PG8_LDA(At, 0, 1); PG8_STAGE(PG8_SB(0, 0), b2, voffB); PG8_STAGE(PG8_SB(0, 1), b2 + hstepB, voffB); PG8_STAGE(PG8_SA(0, 0), a2, voffA);
            PG8_WAIT_V(8); PG8_WAIT_L(0); PG8_BAR; PG8_MMA(1, 0, At, B0); PG8_MMA(1, 1, At, B1); PG8_BAR; PG8_SCHED;
            PG8_LDB(B0, 1, 0); PG8_LDB(B1, 1, 1); PG8_SCHED; PG8_LDA(At, 1, 0); PG8_STAGE(PG8_SA(0, 1), a2 + hstepA, voffA);
            PG8_WAIT_V(8); PG8_WAIT_L(0); PG8_BAR; PG8_MMA(0, 0, At, B0); PG8_MMA(0, 1, At, B1); PG8_BAR; PG8_SCHED;
            PG8_LDA(At, 1, 1); PG8_STAGE(PG8_SB(1, 0), b3, voffB); PG8_STAGE(PG8_SB(1, 1), b3 + hstepB, voffB); PG8_STAGE(PG8_SA(1, 0), a3, voffA);
            PG8_WAIT_V(8); PG8_WAIT_L(0); PG8_BAR; PG8_MMA(1, 0, At, B0); PG8_MMA(1, 1, At, B1); PG8_BAR; PG8_SCHED;
        }
        if (wr == 0) PG8_BAR;
        if constexpr (!Epi::AFTER_DRAIN) E(acc, cur, wr, wc, fr, fq, lds, wid, lane, nxt, has_next, ui);
        if (!has_next) break;
#pragma unroll
        for (int a = 0; a < 2; ++a)
#pragma unroll
            for (int b = 0; b < 2; ++b)
#pragma unroll
                for (int m = 0; m < 4; ++m)
#pragma unroll
                    for (int n = 0; n < 2; ++n) acc[a][b][m][n] = (f32x4){0.f, 0.f, 0.f, 0.f};
        cur = nxt; cA = nA; cB = nB; ++ui;
        if (wr == 1) PG8_BAR;
    }
    PG8_WAIT_V(0);
    PG8_BAR;
    if constexpr (Epi::AFTER_DRAIN) E.fused(acc, cur, wr, wc, fr, fq, lds, wid, lane);
#undef PG8_SA
#undef PG8_SB
#undef PG8_STAGE
#undef PG8_LDA
#undef PG8_LDB
#undef PG8_MMA
#undef PG8_WAIT_V
#undef PG8_WAIT_L
#undef PG8_BAR
#undef PG8_SCHED
}
}

#define GAS __attribute__((address_space(1)))
#define LAS __attribute__((address_space(3)))
typedef unsigned short bf16;
typedef unsigned v4u __attribute__((ext_vector_type(4)));
typedef unsigned v2u __attribute__((ext_vector_type(2)));
typedef float f32x4 __attribute__((ext_vector_type(4)));
typedef float f32x2 __attribute__((ext_vector_type(2)));
using pg8::cvt_pk_bf16;

constexpr int NWAVES = 8, NTHR = 512;
constexpr int DM = 1024, SEQ = 8192, NB = 8, M = NB * SEQ, DEPTH = 2;
constexpr int CW = 512, SW = 512, KC = 31, NG = 32, NP = 64, INC = 1536, FF = 2816;
constexpr int TC = 32;
constexpr int RPG = M / TC;
constexpr int K2 = TC * 16 + 256;
constexpr float EPS = 1e-6f;

constexpr size_t MiB = 1u << 20;
constexpr size_t WS_WL = 0, WL_STRIDE = 22 * MiB;
constexpr size_t OFF_WIN = 0, OFF_GLUW = 3 * MiB, OFF_WOUT = 3 * MiB + 512 * 1024, OFF_WGU = 5 * MiB + 512 * 1024, OFF_WDN = 16 * MiB + 512 * 1024;
constexpr size_t WS_S5 = 44 * MiB, S5_STRIDE = 32 * MiB;
constexpr size_t OFF_BS = 0, OFF_B2 = 8 * MiB;
constexpr size_t WS_ROWPART = 108 * MiB;
constexpr size_t WS_RSS = 116 * MiB;
constexpr size_t WS_BAR = 120 * MiB, BAR_REGION_WORDS = 4096, WS_XB = WS_BAR + 2 * MiB, BAR_BYTES = 4 * MiB;
constexpr size_t WS_AT = 112 * MiB;
constexpr size_t WS_H = 128 * MiB;
constexpr size_t WS_BIG = 256 * MiB;
constexpr size_t WS_CG = 608 * MiB, WS_Z = 672 * MiB, WS_A2 = 736 * MiB, WS_CAT = 832 * MiB;
constexpr size_t WS_END = 960 * MiB;
constexpr int LDS_BYTES = 147456;

struct Frame { LAS unsigned char* lds; int tid, lane, wave, vcu, G; };

__device__ __forceinline__ float wave_sum(float v) {
#pragma unroll
    for (int o = 1; o < 64; o <<= 1) v += __shfl_xor(v, o);
    return v;
}
__device__ __forceinline__ float wave_sum_dpp(float v) {
    v += __int_as_float(__builtin_amdgcn_update_dpp(0, __float_as_int(v), 0xB1, 0xf, 0xf, true));
    v += __int_as_float(__builtin_amdgcn_update_dpp(0, __float_as_int(v), 0x4E, 0xf, 0xf, true));
    v += __int_as_float(__builtin_amdgcn_update_dpp(0, __float_as_int(v), 0x141, 0xf, 0xf, true));
    v += __int_as_float(__builtin_amdgcn_update_dpp(0, __float_as_int(v), 0x140, 0xf, 0xf, true));
    const float r0 = __int_as_float(__builtin_amdgcn_readlane(__float_as_int(v), 0)), r1 = __int_as_float(__builtin_amdgcn_readlane(__float_as_int(v), 16));
    const float r2 = __int_as_float(__builtin_amdgcn_readlane(__float_as_int(v), 32)), r3 = __int_as_float(__builtin_amdgcn_readlane(__float_as_int(v), 48));
    return (r0 + r1) + (r2 + r3);
}
__device__ __forceinline__ float sum_rows4(float v) {
    const auto r = __builtin_amdgcn_permlane16_swap(__float_as_uint(v), __float_as_uint(v), false, false);
    const float a = __uint_as_float(r[0]) + __uint_as_float(r[1]);
    const auto q = __builtin_amdgcn_permlane32_swap(__float_as_uint(a), __float_as_uint(a), false, false);
    return __uint_as_float(q[0]) + __uint_as_float(q[1]);
}
__device__ __forceinline__ float sigmoid_f(float x) { return __builtin_amdgcn_rcpf(1.0f + __builtin_amdgcn_exp2f(-1.4426950408889634f * x)); }
__device__ __forceinline__ float bf_lo(unsigned w) { return __uint_as_float(w << 16); }
__device__ __forceinline__ float bf_hi(unsigned w) { return __uint_as_float(w & 0xffff0000u); }
__device__ __forceinline__ unsigned f2bf(float f) { unsigned u = __float_as_uint(f); return (u + 0x7fffu + ((u >> 16) & 1u)) >> 16; }
__device__ __forceinline__ unsigned pk2(float lo, float hi) { return pg8::cvt_pk_bf16(lo, hi); }

#define XB_TMO      128
#define XB_XCNT(j)  (256  + 64 * (j))
#define XB_XSUB(j)  (1280 + 64 * (j))
#define XB_XGEN(j)  (2304 + 64 * (j))
#define XB_TOP      3328
#define XB_TOPGEN   3392
#define XCD_BAR_WORDS 3456
#define XB_SPIN_CAP (1u << 18)

__device__ __forceinline__ unsigned xb_ld(unsigned* p)              { return __hip_atomic_load(p, __ATOMIC_RELAXED, __HIP_MEMORY_SCOPE_AGENT); }
__device__ __forceinline__ unsigned xb_add(unsigned* p, unsigned v) { return __hip_atomic_fetch_add(p, v, __ATOMIC_RELAXED, __HIP_MEMORY_SCOPE_AGENT); }
__device__ __forceinline__ unsigned xb_xcc_id() { return (unsigned)__builtin_amdgcn_s_getreg((3 << 11) | 20) & 0xFu; }
#define XB_SPIN(cond, bar) do { unsigned _sp = 0; while (cond) { __builtin_amdgcn_s_sleep(1); \
    if ((++_sp & 255u) == 0u) { if (xb_ld(&(bar)[XB_TMO])) break; if (_sp > XB_SPIN_CAP) { atomicAdd(&(bar)[XB_TMO], 1u); break; } } } } while (0)

struct XcdBarrier {
    unsigned* bar; unsigned x; unsigned G;
    volatile LAS unsigned* st;
};

__device__ __forceinline__ XcdBarrier xcd_barrier_post(unsigned* bar, volatile LAS unsigned* st, unsigned G) {
    XcdBarrier b; b.bar = bar; b.x = xb_xcc_id(); b.st = st; b.G = G;
    if (threadIdx.x == 0) (void)xb_add(&bar[XB_XCNT(b.x)], 1u);
    return b;
}
__device__ __forceinline__ void xcd_barrier_complete(unsigned* bar, unsigned x, unsigned G, unsigned& nloc, unsigned& nx) {
    unsigned sum, cnt, mine, sp = 0u;
    for (;;) {
        sum = 0u; cnt = 0u; mine = 0u;
#pragma unroll
        for (unsigned j = 0; j < 16; ++j) { const unsigned c = xb_ld(&bar[XB_XCNT(j)]); sum += c; cnt += (c > 0u) ? 1u : 0u; mine = (j == x) ? c : mine; }
        if (sum == G) break;
        __builtin_amdgcn_s_sleep(1);
        if ((++sp & 255u) == 0u) { if (xb_ld(&bar[XB_TMO])) break; if (sp > XB_SPIN_CAP) { atomicAdd(&bar[XB_TMO], 1u); break; } }
    }
    nloc = mine > 0u ? mine : 1u; nx = cnt > 0u ? cnt : 1u;
}

__device__ __forceinline__ void xcd_barrier(const XcdBarrier& b) {
    asm volatile("s_waitcnt vmcnt(0)" ::: "memory");
    __syncthreads();
    if (threadIdx.x == 0) {
        unsigned* bar = b.bar;
        __builtin_amdgcn_s_waitcnt(0);
        unsigned nloc = b.st[0], nx = b.st[1];
        if (nloc == 0u) { xcd_barrier_complete(bar, b.x, b.G, nloc, nx); b.st[0] = nloc; b.st[1] = nx; }
        const unsigned old = xb_add(&bar[XB_XSUB(b.x)], 1u);
        const unsigned gen = old / nloc;
        if (old + 1u == (gen + 1u) * nloc) {
            __builtin_amdgcn_fence(__ATOMIC_RELEASE, "agent");
            asm volatile("s_waitcnt vmcnt(0)" ::: "memory");
            if (nx > 1u) {
            const unsigned og = xb_add(&bar[XB_TOP], 1u);
            const unsigned tg = og / nx;
            if (og + 1u == (tg + 1u) * nx) xb_add(&bar[XB_TOPGEN], 1u);
            else XB_SPIN(xb_ld(&bar[XB_TOPGEN]) == tg, bar);
            }
            __builtin_amdgcn_fence(__ATOMIC_ACQUIRE, "agent");
            xb_add(&bar[XB_XGEN(b.x)], 1u);
            asm volatile("s_waitcnt vmcnt(0)" ::: "memory");
        } else {
            XB_SPIN(xb_ld(&bar[XB_XGEN(b.x)]) == gen, bar);
            __builtin_amdgcn_fence(__ATOMIC_ACQUIRE, "agent");
            asm volatile("s_waitcnt vmcnt(0)" ::: "memory");
        }
    }
    __syncthreads();
}

constexpr int RS_OFF = 131072 + 10240;
__device__ __forceinline__ float rstd4(const f32x4 q) { return __builtin_amdgcn_rsqf(((q[0] + q[1]) + (q[2] + q[3])) * (1.0f / DM) + EPS); }
__device__ __forceinline__ void rowstat_begin(const float* rss, const pg8::Unit& cur, LAS unsigned char* lds, int tid) {
    if (tid < 256) ((LAS float*)(lds + RS_OFF))[tid] = rstd4(*(const f32x4*)(rss + ((size_t)cur.pm * 256 + tid) * 4));
}

struct EpiProj {
    static constexpr bool AFTER_DRAIN = false;
    __device__ __forceinline__ void begin(const pg8::Unit& cur, LAS unsigned char* lds, int tid) const { rowstat_begin(rss, cur, lds, tid); }
    bf16* CG; bf16* A2; const float* rss;
    __device__ __forceinline__ void operator()(const f32x4 (&acc)[2][2][4][2], const pg8::Unit& u, int wr, int wc, int fr, int fq, LAS unsigned char* lds, int wid, int lane, const pg8::Unit& nxt, bool has_next, int ui) const {
        const int row0 = u.pm * 256 + wr * 64 + fr, tid = wid * 64 + lane;
        const LAS float* R = (const LAS float*)(lds + RS_OFF) + (ui & 1) * 256;
        const bool pre = has_next && tid < 256; f32x4 qn = (f32x4){1.f, 1.f, 1.f, 1.f};
        if (pre) qn = *(const f32x4*)(rss + ((size_t)nxt.pm * 256 + tid) * 4);
        float rs[2][4];
#pragma unroll
        for (int ai = 0; ai < 2; ++ai)
#pragma unroll
            for (int m = 0; m < 4; ++m) rs[ai][m] = R[wr * 64 + fr + ai * 128 + m * 16];
        if (u.pn < 4) {
            const int col = u.pn * 128 + wc * 32 + fq * 8;
#pragma unroll
            for (int ai = 0; ai < 2; ++ai) {
#pragma unroll
                for (int m = 0; m < 4; ++m) {
                    const int row = row0 + ai * 128 + m * 16; const float r_ = rs[ai][m];
                    const f32x4 v0 = acc[ai][0][m][0] * r_, v1 = acc[ai][0][m][1] * r_, g0 = acc[ai][1][m][0] * r_, g1 = acc[ai][1][m][1] * r_;
                    v4u w;
                    w.x = cvt_pk_bf16(v0[0] * sigmoid_f(g0[0]), v0[1] * sigmoid_f(g0[1])); w.y = cvt_pk_bf16(v0[2] * sigmoid_f(g0[2]), v0[3] * sigmoid_f(g0[3]));
                    w.z = cvt_pk_bf16(v1[0] * sigmoid_f(g1[0]), v1[1] * sigmoid_f(g1[1])); w.w = cvt_pk_bf16(v1[2] * sigmoid_f(g1[2]), v1[3] * sigmoid_f(g1[3]));
                    *(v4u*)(CG + (size_t)row * CW + col) = w;
                }
                if (ai == 0) {
                    __builtin_amdgcn_sched_barrier(0);
                    float rn = rstd4(qn); asm volatile("" : "+v"(rn));
                    if (pre) ((LAS float*)(lds + RS_OFF))[((ui + 1) & 1) * 256 + tid] = rn;
                    __builtin_amdgcn_sched_barrier(0);
                }
            }
        } else {
#pragma unroll
            for (int ai = 0; ai < 2; ++ai) {
#pragma unroll
                for (int m = 0; m < 4; ++m) {
                    const int tok = row0 + ai * 128 + m * 16, r = tok >> 5, t = tok & 31;
#pragma unroll
                    for (int bj = 0; bj < 2; ++bj) {
                        const int cu = (u.pn - 4) * 256 + bj * 128 + wc * 32 + fq * 8, gg = cu >> 4, h0 = cu & 15;
                        const f32x4 v0 = acc[ai][bj][m][0] * rs[ai][m], v1 = acc[ai][bj][m][1] * rs[ai][m];
                        v4u w; w.x = cvt_pk_bf16(v0[0], v0[1]); w.y = cvt_pk_bf16(v0[2], v0[3]); w.z = cvt_pk_bf16(v1[0], v1[1]); w.w = cvt_pk_bf16(v1[2], v1[3]);
                        *(v4u*)(A2 + ((size_t)(gg * RPG + r) * K2 + t * 16 + h0)) = w;
                    }
                }
                if (ai == 0) {
                    __builtin_amdgcn_sched_barrier(0);
                    float rn = rstd4(qn); asm volatile("" : "+v"(rn));
                    if (pre) ((LAS float*)(lds + RS_OFF))[((ui + 1) & 1) * 256 + tid] = rn;
                    __builtin_amdgcn_sched_barrier(0);
                }
            }
        }
    }
};
struct EpiF32 {
    static constexpr bool AFTER_DRAIN = false;
    __device__ __forceinline__ void begin(const pg8::Unit&, LAS unsigned char*, int) const {}
    float* O;
    __device__ __forceinline__ void operator()(const f32x4 (&acc)[2][2][4][2], const pg8::Unit& u, int wr, int wc, int fr, int fq, LAS unsigned char* lds, int wid, int lane, const pg8::Unit& nxt, bool has_next, int ui) const {
        const int row0 = u.pm * 256 + wr * 64 + fr;
#pragma unroll
        for (int ai = 0; ai < 2; ++ai)
#pragma unroll
            for (int m = 0; m < 4; ++m) {
                float* rp = O + (size_t)(row0 + ai * 128 + m * 16) * 256 + wc * 32 + fq * 8;
#pragma unroll
                for (int bj = 0; bj < 2; ++bj) { *(f32x4*)(rp + bj * 128) = acc[ai][bj][m][0]; *(f32x4*)(rp + bj * 128 + 4) = acc[ai][bj][m][1]; }
            }
    }
};
struct EpiS5 {
    static constexpr bool AFTER_DRAIN = false;
    __device__ __forceinline__ void begin(const pg8::Unit&, LAS unsigned char*, int) const {}
    bf16* Z;
    __device__ __forceinline__ void operator()(const f32x4 (&acc)[2][2][4][2], const pg8::Unit& u, int wr, int wc, int fr, int fq, LAS unsigned char* lds, int wid, int lane, const pg8::Unit& nxt, bool has_next, int ui) const {
        const int gg = u.pm >> 3, pnl = u.pn & 1;
        const int rl0 = (u.pm & 7) * 256 + wr * 64 + fr;
#pragma unroll
        for (int ai = 0; ai < 2; ++ai)
#pragma unroll
            for (int m = 0; m < 4; ++m) {
                const int tok0 = (rl0 + ai * 128 + m * 16) * TC;
#pragma unroll
                for (int bj = 0; bj < 2; ++bj) {
                    const int t = 16 * pnl + 8 * bj + 2 * wc + (fq >> 1), h0 = 8 * (fq & 1);
                    float o[8];
#pragma unroll
                    for (int e = 0; e < 8; ++e) { const float y = acc[ai][bj][m][e >> 2][e & 3]; o[e] = y * sigmoid_f(1.5957691216f * y * (1.0f + 0.044715f * y * y)); }
                    v4u w; w.x = cvt_pk_bf16(o[0], o[1]); w.y = cvt_pk_bf16(o[2], o[3]); w.z = cvt_pk_bf16(o[4], o[5]); w.w = cvt_pk_bf16(o[6], o[7]);
                    *(v4u*)(Z + ((size_t)(tok0 + t) * SW + gg * 16 + h0)) = w;
                }
            }
    }
};
struct EpiGate {
    static constexpr bool AFTER_DRAIN = false;
    __device__ __forceinline__ void begin(const pg8::Unit&, LAS unsigned char*, int) const {}
    const bf16* Z; bf16* CAT; const float* bias;
    __device__ __forceinline__ void operator()(const f32x4 (&acc)[2][2][4][2], const pg8::Unit& u, int wr, int wc, int fr, int fq, LAS unsigned char* lds, int wid, int lane, const pg8::Unit& nxt, bool has_next, int ui) const {
        const int row0 = u.pm * 256 + wr * 64 + fr, col0 = u.pn * 256 + wc * 32 + fq * 8;
        f32x4 bv[2][2];
#pragma unroll
        for (int bj = 0; bj < 2; ++bj)
#pragma unroll
            for (int n = 0; n < 2; ++n) bv[bj][n] = *(const f32x4*)(bias + col0 + bj * 128 + 4 * n);
        v4u zall[2][4][2];
#pragma unroll
        for (int ai = 0; ai < 2; ++ai)
#pragma unroll
            for (int m = 0; m < 4; ++m)
#pragma unroll
                for (int bj = 0; bj < 2; ++bj) zall[ai][m][bj] = *(const v4u*)(Z + (size_t)(row0 + ai * 128 + m * 16) * SW + col0 + bj * 128);
#pragma unroll
        for (int ai = 0; ai < 2; ++ai)
#pragma unroll
            for (int m = 0; m < 4; ++m) {
                const int row = row0 + ai * 128 + m * 16;
#pragma unroll
                for (int bj = 0; bj < 2; ++bj) {
                    const int col = col0 + bj * 128;
                    const v4u zv = zall[ai][m][bj];
                    const f32x4 g0 = acc[ai][bj][m][0] + bv[bj][0], g1 = acc[ai][bj][m][1] + bv[bj][1];
                    v4u w;
                    w.x = cvt_pk_bf16(bf_lo(zv.x) * sigmoid_f(g0[0]), bf_hi(zv.x) * sigmoid_f(g0[1])); w.y = cvt_pk_bf16(bf_lo(zv.y) * sigmoid_f(g0[2]), bf_hi(zv.y) * sigmoid_f(g0[3]));
                    w.z = cvt_pk_bf16(bf_lo(zv.z) * sigmoid_f(g1[0]), bf_hi(zv.z) * sigmoid_f(g1[1])); w.w = cvt_pk_bf16(bf_lo(zv.w) * sigmoid_f(g1[2]), bf_hi(zv.w) * sigmoid_f(g1[3]));
                    *(v4u*)(CAT + (size_t)row * DM + SW + col) = w;
                }
            }
    }
};
struct EpiNormOut {
    static constexpr bool AFTER_DRAIN = false;
    __device__ __forceinline__ void begin(const pg8::Unit&, LAS unsigned char*, int) const {}
    bf16* O; float* rowpart;
    __device__ __forceinline__ void operator()(const f32x4 (&acc)[2][2][4][2], const pg8::Unit& u, int wr, int wc, int fr, int fq, LAS unsigned char* lds, int wid, int lane, const pg8::Unit& nxt, bool has_next, int ui) const {
        const int row0 = u.pm * 256 + wr * 64 + fr, col0 = u.pn * 256 + wc * 32 + fq * 8;
#pragma unroll
        for (int ai = 0; ai < 2; ++ai)
#pragma unroll
            for (int m = 0; m < 4; ++m) {
                const int row = row0 + ai * 128 + m * 16; float ss = 0.f;
#pragma unroll
                for (int bj = 0; bj < 2; ++bj) {
                    const f32x4 v0 = acc[ai][bj][m][0], v1 = acc[ai][bj][m][1];
                    ss += (v0[0] * v0[0] + v0[1] * v0[1]) + (v0[2] * v0[2] + v0[3] * v0[3]) + (v1[0] * v1[0] + v1[1] * v1[1]) + (v1[2] * v1[2] + v1[3] * v1[3]);
                    v4u w; w.x = cvt_pk_bf16(v0[0], v0[1]); w.y = cvt_pk_bf16(v0[2], v0[3]); w.z = cvt_pk_bf16(v1[0], v1[1]); w.w = cvt_pk_bf16(v1[2], v1[3]);
                    *(v4u*)(O + (size_t)row * DM + col0 + bj * 128) = w;
                }
                ss += __shfl_xor(ss, 16); ss += __shfl_xor(ss, 32);
                if (fq == 0) rowpart[(size_t)row * 16 + u.pn * 4 + wc] = ss;
            }
    }
};
template <bool FINAL>
struct EpiResNorm {
    static constexpr bool AFTER_DRAIN = false;
    __device__ __forceinline__ void begin(const pg8::Unit&, LAS unsigned char*, int) const {}
    bf16* X; const float* gpost; unsigned long long* xb; unsigned tag; float* rssp; float* out;
    __device__ __forceinline__ void operator()(const f32x4 (&acc)[2][2][4][2], const pg8::Unit& u, int wr, int wc, int fr, int fq, LAS unsigned char* lds, int wid, int lane, const pg8::Unit& nxt, bool has_next, int ui) const {
        LAS float* P = (LAS float*)(lds + 131072); LAS float* S = P + 1024; LAS float* Q = S + 256;
        const int tid = wid * 64 + lane, col0 = u.pn * 256 + wc * 32 + fq * 8, rl0 = wr * 64 + fr;
        const size_t rowbase = (size_t)u.pm * 256;
        v4u xv[4][2];
#pragma unroll
        for (int m = 0; m < 4; ++m)
#pragma unroll
            for (int bj = 0; bj < 2; ++bj) xv[m][bj] = *(const v4u*)(X + (rowbase + rl0 + m * 16) * DM + col0 + bj * 128);
        f32x4 gv[2][2];
#pragma unroll
        for (int bj = 0; bj < 2; ++bj)
#pragma unroll
            for (int n = 0; n < 2; ++n) gv[bj][n] = *(const f32x4*)(gpost + col0 + bj * 128 + 4 * n);
#pragma unroll
        for (int ai = 0; ai < 2; ++ai)
#pragma unroll
            for (int m = 0; m < 4; ++m) { float ss = 0.f;
#pragma unroll
                for (int bj = 0; bj < 2; ++bj)
#pragma unroll
                    for (int n = 0; n < 2; ++n) { const f32x4 v = acc[ai][bj][m][n]; ss += (v[0] * v[0] + v[1] * v[1]) + (v[2] * v[2] + v[3] * v[3]); }
                ss = sum_rows4(ss);
                P[(rl0 + ai * 128 + m * 16) * 4 + wc] = ss; }
        asm volatile("s_waitcnt lgkmcnt(0)" ::: "memory"); __builtin_amdgcn_s_barrier(); asm volatile("" ::: "memory");
        if (tid < 256) {
            const f32x4 p = *(const LAS f32x4*)(P + tid * 4);
            unsigned long long* sl = xb + (rowbase + tid) * 4;
            __hip_atomic_store(sl + u.pn, ((unsigned long long)tag << 32) | (unsigned long long)__float_as_uint((p[0] + p[1]) + (p[2] + p[3])), __ATOMIC_RELAXED, __HIP_MEMORY_SCOPE_AGENT);
            float t = 0.f; unsigned sp = 0;
            for (;;) { bool ok = true; t = 0.f;
#pragma unroll
                for (int k = 0; k < 4; ++k) { const unsigned long long w = __hip_atomic_load(sl + k, __ATOMIC_RELAXED, __HIP_MEMORY_SCOPE_AGENT); ok = ok && ((unsigned)(w >> 32) == tag); t += __uint_as_float((unsigned)w); }
                if (ok || ++sp > (1u << 20)) break;
                __builtin_amdgcn_s_sleep(1); }
            S[tid] = __builtin_amdgcn_rsqf(t * (1.0f / DM) + EPS); }
        asm volatile("s_waitcnt lgkmcnt(0)" ::: "memory"); __builtin_amdgcn_s_barrier(); asm volatile("" ::: "memory");
#define RESNORM_ROWGROUP(ai, m) do { const int rl = rl0 + (ai) * 128 + (m) * 16; const float rstd = S[rl]; float ss2 = 0.f; \
            _Pragma("unroll") for (int bj = 0; bj < 2; ++bj) { const v4u xw = xv[m][bj]; const f32x4 y0 = acc[ai][bj][m][0] * rstd * gv[bj][0], y1 = acc[ai][bj][m][1] * rstd * gv[bj][1]; \
                const f32x4 o0 = (f32x4){bf_lo(xw.x) + y0[0], bf_hi(xw.x) + y0[1], bf_lo(xw.y) + y0[2], bf_hi(xw.y) + y0[3]}; \
                const f32x4 o1 = (f32x4){bf_lo(xw.z) + y1[0], bf_hi(xw.z) + y1[1], bf_lo(xw.w) + y1[2], bf_hi(xw.w) + y1[3]}; \
                if (FINAL) { float* op = out + (rowbase + rl) * DM + col0 + bj * 128; *(f32x4*)op = o0; *(f32x4*)(op + 4) = o1; } \
                else { v4u w; w.x = cvt_pk_bf16(o0[0], o0[1]); w.y = cvt_pk_bf16(o0[2], o0[3]); w.z = cvt_pk_bf16(o1[0], o1[1]); w.w = cvt_pk_bf16(o1[2], o1[3]); \
                    _Pragma("unroll") for (int e = 0; e < 4; ++e) { const float a = bf_lo(w[e]), b = bf_hi(w[e]); ss2 += a * a + b * b; } \
                    *(v4u*)(X + (rowbase + rl) * DM + col0 + bj * 128) = w; } } \
            if (!FINAL) { ss2 = sum_rows4(ss2); Q[rl * 4 + wc] = ss2; } } while (0)
#pragma unroll
        for (int m = 0; m < 4; ++m) { RESNORM_ROWGROUP(0, m);
#pragma unroll
            for (int bj = 0; bj < 2; ++bj) xv[m][bj] = *(const v4u*)(X + (rowbase + rl0 + 128 + m * 16) * DM + col0 + bj * 128); }
#pragma unroll
        for (int m = 0; m < 4; ++m) RESNORM_ROWGROUP(1, m);
#undef RESNORM_ROWGROUP
        if (!FINAL) {
            asm volatile("s_waitcnt lgkmcnt(0)" ::: "memory"); __builtin_amdgcn_s_barrier(); asm volatile("" ::: "memory");
            if (tid < 256) { const f32x4 q = *(const LAS f32x4*)(Q + tid * 4); rssp[(rowbase + tid) * 4 + u.pn] = (q[0] + q[1]) + (q[2] + q[3]); }
        }
    }
};
struct EpiSwiGLU {
    static constexpr bool AFTER_DRAIN = false;
    __device__ __forceinline__ void begin(const pg8::Unit& cur, LAS unsigned char* lds, int tid) const { rowstat_begin(rss, cur, lds, tid); }
    bf16* ACT; const float* rss;
    __device__ __forceinline__ void operator()(const f32x4 (&acc)[2][2][4][2], const pg8::Unit& u, int wr, int wc, int fr, int fq, LAS unsigned char* lds, int wid, int lane, const pg8::Unit& nxt, bool has_next, int ui) const {
        const int row0 = u.pm * 256 + wr * 64 + fr, col = u.pn * 128 + wc * 32 + fq * 8, tid = wid * 64 + lane;
        const LAS float* R = (const LAS float*)(lds + RS_OFF) + (ui & 1) * 256;
        const bool pre = has_next && tid < 256; f32x4 qn = (f32x4){1.f, 1.f, 1.f, 1.f};
        if (pre) qn = *(const f32x4*)(rss + ((size_t)nxt.pm * 256 + tid) * 4);
#pragma unroll
        for (int ai = 0; ai < 2; ++ai) {
#pragma unroll
            for (int m = 0; m < 4; ++m) {
                const int row = row0 + ai * 128 + m * 16; const float r_ = R[wr * 64 + fr + ai * 128 + m * 16];
                const f32x4 g0 = acc[ai][0][m][0] * r_, g1 = acc[ai][0][m][1] * r_, u0 = acc[ai][1][m][0] * r_, u1 = acc[ai][1][m][1] * r_;
                v4u w;
                w.x = cvt_pk_bf16(g0[0] * sigmoid_f(g0[0]) * u0[0], g0[1] * sigmoid_f(g0[1]) * u0[1]); w.y = cvt_pk_bf16(g0[2] * sigmoid_f(g0[2]) * u0[2], g0[3] * sigmoid_f(g0[3]) * u0[3]);
                w.z = cvt_pk_bf16(g1[0] * sigmoid_f(g1[0]) * u1[0], g1[1] * sigmoid_f(g1[1]) * u1[1]); w.w = cvt_pk_bf16(g1[2] * sigmoid_f(g1[2]) * u1[2], g1[3] * sigmoid_f(g1[3]) * u1[3]);
                *(v4u*)(ACT + (size_t)row * FF + col) = w;
            }
            if (ai == 0) {
                __builtin_amdgcn_sched_barrier(0);
                float rn = rstd4(qn); asm volatile("" : "+v"(rn));
                if (pre) ((LAS float*)(lds + RS_OFF))[((ui + 1) & 1) * 256 + tid] = rn;
                __builtin_amdgcn_sched_barrier(0);
            }
        }
    }
};
struct EpiScan {
    static constexpr bool AFTER_DRAIN = true;
    __device__ __forceinline__ void begin(const pg8::Unit&, LAS unsigned char*, int) const {}
    bf16* A2; const f32x2* AT; int l;
    __device__ __forceinline__ void fused(const f32x4 (&acc)[2][2][4][2], const pg8::Unit& u, int wr, int wc, int fr, int fq, LAS unsigned char* lds, int wid, int lane) const {
        LAS float* T = (LAS float*)lds; constexpr int TP = 132;
        const int g = u.pm >> 3;
        const size_t row0 = (size_t)u.pm * 256;
#pragma unroll
        for (int bj = 0; bj < 2; ++bj) {
#pragma unroll
            for (int ai = 0; ai < 2; ++ai)
#pragma unroll
                for (int m = 0; m < 4; ++m) { LAS float* tp = T + (ai * 128 + wr * 64 + m * 16 + fr) * TP + wc * 32 + fq * 8;
                    *(LAS f32x4*)tp = acc[ai][bj][m][0]; *(LAS f32x4*)(tp + 4) = acc[ai][bj][m][1]; }
            asm volatile("s_waitcnt lgkmcnt(0)" ::: "memory"); __builtin_amdgcn_s_barrier(); asm volatile("" ::: "memory");
            if (wid == 0) {
                const int p = lane, d = bj;
                const f32x2 a = AT[((l * NG + g) * 2 + d) * NP + p];
                float xr = 0.f, xi = 0.f;
                for (int i0 = 0; i0 < 256; i0 += 8) {
                    float sr[8], si[8];
#pragma unroll
                    for (int i = 0; i < 8; ++i) { const int c = d == 0 ? i0 + i : 255 - (i0 + i); sr[i] = T[c * TP + p]; si[i] = T[c * TP + 64 + p]; }
#pragma unroll
                    for (int i = 0; i < 8; ++i) { const int c = d == 0 ? i0 + i : 255 - (i0 + i);
                        T[c * TP + p] = xr; T[c * TP + 64 + p] = xi;
                        const float nr = a.x * xr - a.y * xi + sr[i]; xi = a.x * xi + a.y * xr + si[i]; xr = nr; }
                }
            }
            asm volatile("s_waitcnt lgkmcnt(0)" ::: "memory"); __builtin_amdgcn_s_barrier(); asm volatile("" ::: "memory");
            {
                const int tid = wid * 64 + lane;
#pragma unroll
                for (int q = 0; q < 8; ++q) { const int e = q * 512 + tid, c = e >> 4, k8 = (e & 15) * 8;
                    const f32x4 v0 = *(const LAS f32x4*)(T + c * TP + k8), v1 = *(const LAS f32x4*)(T + c * TP + k8 + 4);
                    v4u w; w.x = cvt_pk_bf16(v0[0], v0[1]); w.y = cvt_pk_bf16(v0[2], v0[3]); w.z = cvt_pk_bf16(v1[0], v1[1]); w.w = cvt_pk_bf16(v1[2], v1[3]);
                    *(v4u*)(A2 + (row0 + c) * K2 + 512 + bj * 128 + k8) = w; }
            }
            asm volatile("s_waitcnt vmcnt(0) lgkmcnt(0)" ::: "memory"); __builtin_amdgcn_s_barrier(); asm volatile("" ::: "memory");
        }
    }
};
struct OrderG4 {
    int c;
    __device__ bool next(int i, pg8::Unit& u) const {
        if (i >= 22) return false;
        const int x = c & 7, j = c >> 3;
        if (i < 20) { u.pm = 32 * x + 8 * (i & 3) + (j & 7); u.pn = 4 * (i >> 2) + (j >> 3); }
        else        { u.pm = 32 * x + 16 * (i - 20) + (j & 15); u.pn = 20 + (j >> 4); }
        return true;
    }
};
struct OrderS1 { int vcu; __device__ bool next(int i, pg8::Unit& u) const { if (i > 0) return false; u.pm = 8 * (vcu & 31) + (vcu >> 5); u.pn = vcu & 31; return true; } };
struct OrderS2 { int vcu; __device__ bool next(int i, pg8::Unit& u) const { if (i > 1) return false; u.pm = 8 * (vcu & 31) + (vcu >> 5); u.pn = (vcu & 31) * 2 + i; return true; } };

__device__ __forceinline__ void transpose_item(const float* W, int K, int N, bf16* WT, int k0, int n0, int dst0, LAS float* scr, int lane, const float* gain = nullptr) {
    float tv[32];
#pragma unroll
    for (int i = 0; i < 32; ++i) { const int kk = 2 * i + (lane >> 5); tv[i] = W[(size_t)(k0 + kk) * N + n0 + (lane & 31)]; }
    if (gain) {
#pragma unroll
        for (int i = 0; i < 32; ++i) tv[i] *= gain[k0 + 2 * i + (lane >> 5)];
    }
#pragma unroll
    for (int i = 0; i < 32; ++i) { const int kk = 2 * i + (lane >> 5); scr[kk * 33 + (lane & 31)] = tv[i]; }
    asm volatile("s_waitcnt lgkmcnt(0)" ::: "memory");
    const int c = lane & 7;
#pragma unroll
    for (int j = 0; j < 4; ++j) { const int n = (lane >> 3) + 8 * j; const LAS float* s = scr + (8 * c) * 33 + n;
        v4u o; o.x = pk2(s[0 * 33], s[1 * 33]); o.y = pk2(s[2 * 33], s[3 * 33]); o.z = pk2(s[4 * 33], s[5 * 33]); o.w = pk2(s[6 * 33], s[7 * 33]);
        *(v4u*)(WT + (size_t)(dst0 + n) * K + k0 + 8 * c) = o; }
    asm volatile("s_waitcnt lgkmcnt(0)" ::: "memory");
}
__device__ __forceinline__ int glu_row(int j) { return 256 * (j >> 7) + (j & 127); }

__device__ __forceinline__ double exp_d(double x) {
    const double k = rint(x * 1.4426950408889634); double r = fma(-k, 0.6931471805599453, x); r = fma(-k, 2.3190468138462996e-17, r);
    double s = 1.0, term = 1.0;
#pragma unroll
    for (int i = 1; i <= 14; ++i) { term *= r * (1.0 / i); s += term; }
    const long long e = (long long)k + 1023; return s * __longlong_as_double(e << 52);
}
__device__ __forceinline__ void sincos_d(double th, double& sn, double& cs) {
    const double n = rint(th * 0.15915494309189535); double r = fma(-n, 6.283185307179586, th); r = fma(-n, 2.4492935982947064e-16, r);
    const double r2 = r * r; double ts = r, tc = 1.0; sn = r; cs = 1.0;
#pragma unroll
    for (int i = 1; i <= 15; ++i) { tc *= -r2 * (1.0 / ((2.0 * i - 1.0) * (2.0 * i))); cs += tc; ts *= -r2 * (1.0 / ((2.0 * i) * (2.0 * i + 1.0))); sn += ts; }
}

__device__ __forceinline__ void s5_build(const Frame& F, const float* const* in, unsigned char* ws, int l, int g) {
    LAS f32x2* pw = (LAS f32x2*)F.lds;
    LAS f32x2* Bb = (LAS f32x2*)(F.lds + 33792);
    LAS f32x2* Cc = (LAS f32x2*)(F.lds + 33792 + 16384);
    LAS float* Kt = (LAS float*)(F.lds + 33792 + 32768);
    int tid_ = F.tid; asm volatile("" : "+v"(tid_));
    const int tid = tid_;
    const float* a_re = in[8]; const float* a_im = in[9]; const float* log_dt = in[10]; const float* b_re = in[11]; const float* b_im = in[12];
    const float* c_re = in[13]; const float* c_im = in[14]; const float* dsk = in[15];
    if (tid < 128) {
        const int d = tid >> 6, p = tid & 63, ld = (l * 2 + d) * NG + g;
        const double are = a_re[ld * NP + p], aim = a_im[ld * NP + p], dt = exp_d((double)log_dt[ld]);
        double sn, cs; sincos_d(aim * dt, sn, cs); const double mg = exp_d(are * dt), abr = mg * cs, abi = mg * sn;
        double cr = 1.0, ci = 0.0;
        for (int k = 0; k <= TC; ++k) { pw[(d * 64 + p) * 33 + k] = (f32x2){(float)cr, (float)ci}; const double nr = cr * abr - ci * abi; ci = cr * abi + ci * abr; cr = nr; }
        {
            const f32x2 w = pw[(d * 64 + p) * 33 + TC]; ((f32x2*)(ws + WS_AT))[((l * NG + g) * 2 + d) * NP + p] = w;
        }
        const double nr = abr - 1.0, ni = abi, den = are * are + aim * aim, qr = (nr * are + ni * aim) / den, qi = (ni * are - nr * aim) / den;
#pragma unroll 4
        for (int h = 0; h < 16; ++h) { const double br = b_re[(ld * NP + p) * 16 + h], bi = b_im[(ld * NP + p) * 16 + h]; Bb[(d * 64 + p) * 16 + h] = (f32x2){(float)(qr * br - qi * bi), (float)(qr * bi + qi * br)}; }
    }
    for (int e = tid; e < 2048; e += NTHR) { const int d = e >> 10, h = (e >> 6) & 15, p = e & 63, idx = (((l * 2 + d) * NG + g) * 16 + h) * NP + p; Cc[e] = (f32x2){c_re[idx], c_im[idx]}; }
    __syncthreads();
    {
        const int d = tid >> 8, h = (tid >> 4) & 15, hp = tid & 15;
        float acc[TC];
#pragma unroll
        for (int k = 0; k < TC; ++k) acc[k] = 0.f;
        for (int p = 0; p < NP; ++p) {
            const f32x2 c = Cc[(d * 16 + h) * 64 + p], b = Bb[(d * 64 + p) * 16 + hp];
            const float cbr = c.x * b.x - c.y * b.y, cbi = c.x * b.y + c.y * b.x;
#pragma unroll
            for (int k = 0; k < TC; ++k) { const f32x2 w = pw[(d * 64 + p) * 33 + k]; acc[k] += cbr * w.x - cbi * w.y; }
        }
#pragma unroll
        for (int k = 0; k < TC; ++k) Kt[((d * TC + k) * 16 + h) * 16 + hp] = acc[k];
    }
    __syncthreads();
    bf16* B2 = (bf16*)(ws + WS_S5 + (size_t)l * S5_STRIDE + OFF_B2) + (size_t)g * 512 * K2;
    bf16* BS = (bf16*)(ws + WS_S5 + (size_t)l * S5_STRIDE + OFF_BS) + (size_t)g * 256 * 512;
    for (int q = tid; q < 512 * 64; q += NTHR) {
        const int n = q >> 6, kc = q & 63, t = n >> 4, h = n & 15, s = kc >> 1, h0 = (kc & 1) * 8;
        float v[8];
        const int d = (t >= s) ? 0 : 1, lag = (t >= s) ? (t - s) : (s - t);
        const LAS float* kp = Kt + ((d * TC + lag) * 16 + h) * 16 + h0;
#pragma unroll
        for (int e = 0; e < 8; ++e) v[e] = kp[e];
        if (t == s) { const LAS float* k1 = Kt + ((1 * TC + 0) * 16 + h) * 16 + h0; const float dv = dsk[l * SW + g * 16 + h];
#pragma unroll
            for (int e = 0; e < 8; ++e) v[e] += k1[e] + ((h0 + e == h) ? dv : 0.f); }
        v4u o; o.x = pk2(v[0], v[1]); o.y = pk2(v[2], v[3]); o.z = pk2(v[4], v[5]); o.w = pk2(v[6], v[7]);
        *(v4u*)(B2 + (size_t)n * K2 + kc * 8) = o;
    }
    for (int q = tid; q < 512 * 32; q += NTHR) {
        const int n = q >> 5, jc = q & 31, t = n >> 4, h = n & 15, j0 = jc * 8, sec = j0 >> 6, p0 = j0 & 63, d = sec >> 1, kk = d == 0 ? t + 1 : TC - t;
        float v[8];
#pragma unroll
        for (int e = 0; e < 8; ++e) { const f32x2 c = Cc[(d * 16 + h) * 64 + p0 + e], w = pw[(d * 64 + p0 + e) * 33 + kk]; v[e] = (sec & 1) ? -(c.x * w.y + c.y * w.x) : (c.x * w.x - c.y * w.y); }
        v4u o; o.x = pk2(v[0], v[1]); o.y = pk2(v[2], v[3]); o.z = pk2(v[4], v[5]); o.w = pk2(v[6], v[7]);
        *(v4u*)(B2 + (size_t)n * K2 + 512 + j0) = o;
    }
    for (int q = tid; q < 256 * 64; q += NTHR) {
        const int j = q >> 6, kc = q & 63, s = kc >> 1, h0 = (kc & 1) * 8, sec = j >> 6, p = j & 63, d = sec >> 1, kk = d == 0 ? TC - 1 - s : s;
        const f32x2 w = pw[(d * 64 + p) * 33 + kk];
        float v[8];
#pragma unroll
        for (int e = 0; e < 8; ++e) { const f32x2 b = Bb[(d * 64 + p) * 16 + h0 + e]; v[e] = (sec & 1) ? (w.x * b.y + w.y * b.x) : (w.x * b.x - w.y * b.y); }
        v4u o; o.x = pk2(v[0], v[1]); o.y = pk2(v[2], v[3]); o.z = pk2(v[4], v[5]); o.w = pk2(v[6], v[7]);
        *(v4u*)(BS + (size_t)j * 512 + kc * 8) = o;
    }
    __syncthreads();
}

template <int MODE>
__device__ __forceinline__ void e_phase(const Frame& F, const float* xin, bf16* X, const bf16* y, const float* rowpart, const float* gpost, float* rss, float* out) {
    int lane_ = F.lane; asm volatile("" : "+v"(lane_));
    constexpr int ER = 4;
    const int gw = (MODE == 0 ? F.vcu - DEPTH * NG : F.vcu) * NWAVES + F.wave, NGW = (MODE == 0 ? F.G - DEPTH * NG : F.G) * NWAVES, lane = lane_;
    f32x4 gp[2][2];
#pragma unroll
    for (int j = 0; j < 2; ++j)
#pragma unroll
        for (int n = 0; n < 2; ++n) gp[j][n] = MODE ? *(const f32x4*)(gpost + 8 * lane + 512 * j + 4 * n) : (f32x4){0.f, 0.f, 0.f, 0.f};
    for (int m0 = (gw < 0 ? M : gw * ER); m0 < M; m0 += NGW * ER) {
        v4u xv[ER][2], yv[ER][2]; f32x4 xf[ER][2][2]; float rp[ER];
#pragma unroll
        for (int r = 0; r < ER; ++r) { const size_t off = (size_t)(m0 + r) * DM + 8 * lane;
            if (MODE == 0) {
#pragma unroll
                for (int j = 0; j < 2; ++j) { xf[r][j][0] = *(const f32x4*)(xin + off + 512 * j); xf[r][j][1] = *(const f32x4*)(xin + off + 512 * j + 4); }
            } else {
#pragma unroll
                for (int j = 0; j < 2; ++j) { xv[r][j] = *(const v4u*)(X + off + 512 * j); yv[r][j] = *(const v4u*)(y + off + 512 * j); }
                rp[r] = rowpart[(size_t)(m0 + r) * 16 + (lane & 15)];
            } }
#pragma unroll
        for (int r = 0; r < ER; ++r) { const size_t off = (size_t)(m0 + r) * DM + 8 * lane;
            float v[2][8];
            if (MODE == 0) {
#pragma unroll
                for (int j = 0; j < 2; ++j)
#pragma unroll
                    for (int e = 0; e < 4; ++e) { v[j][e] = xf[r][j][0][e]; v[j][4 + e] = xf[r][j][1][e]; }
            } else {
                float q = rp[r]; q += __shfl_xor(q, 1); q += __shfl_xor(q, 2); q += __shfl_xor(q, 4); q += __shfl_xor(q, 8);
                const float rstd = 1.0f / sqrtf(q * (1.0f / DM) + EPS);
#pragma unroll
                for (int j = 0; j < 2; ++j)
#pragma unroll
                    for (int e = 0; e < 4; ++e) {
                        v[j][2 * e] = bf_lo(xv[r][j][e]) + bf_lo(yv[r][j][e]) * rstd * gp[j][e >> 1][(2 * e) & 3];
                        v[j][2 * e + 1] = bf_hi(xv[r][j][e]) + bf_hi(yv[r][j][e]) * rstd * gp[j][e >> 1][(2 * e + 1) & 3];
                    }
            }
            if (MODE == 2) {
#pragma unroll
                for (int j = 0; j < 2; ++j) { *(f32x4*)(out + off + 512 * j) = (f32x4){v[j][0], v[j][1], v[j][2], v[j][3]}; *(f32x4*)(out + off + 512 * j + 4) = (f32x4){v[j][4], v[j][5], v[j][6], v[j][7]}; }
            } else {
                float s = 0.f;
#pragma unroll
                for (int j = 0; j < 2; ++j) {
                    v4u o; o.x = cvt_pk_bf16(v[j][0], v[j][1]); o.y = cvt_pk_bf16(v[j][2], v[j][3]); o.z = cvt_pk_bf16(v[j][4], v[j][5]); o.w = cvt_pk_bf16(v[j][6], v[j][7]);
#pragma unroll
                    for (int e = 0; e < 4; ++e) { const float a = bf_lo(o[e]), b = bf_hi(o[e]); s += a * a + b * b; }
                    *(v4u*)(X + off + 512 * j) = o;
                }
                s = wave_sum_dpp(s);
                if (lane == 0) *(f32x4*)(rss + (size_t)(m0 + r) * 4) = (f32x4){s, 0.f, 0.f, 0.f};
            }
        }
    }
}

__device__ __forceinline__ void p0_prologue(const Frame& F, const float* const* in, unsigned char* ws) {
    LAS float* scr = (LAS float*)(F.lds + F.wave * 16384);
    const int NS5 = DEPTH * NG;
    const int gw = (F.vcu - NS5) * NWAVES + F.wave, NGW = (F.G - NS5) * NWAVES;
    constexpr int I_IN = 16 * 48, I_GLU = 8 * 16, I_OUT = 16 * 32, I_GT = 16 * 88, I_DN = 44 * 32, I_L = I_IN + I_GLU + I_OUT + 2 * I_GT + I_DN;
    if (F.vcu >= NS5)
    for (int it = gw; it < DEPTH * I_L; it += NGW) {
        const int l = it / I_L; int r = it % I_L;
        unsigned char* wl = ws + WS_WL + (size_t)l * WL_STRIDE;
        if (r < I_IN) { const int kb = r / 48, nb = r % 48, n0 = nb * 32; const int dst = n0 < 512 ? glu_row(n0) : (n0 < 1024 ? glu_row(n0 - 512) + 128 : n0);
            transpose_item(in[3] + (size_t)l * DM * INC, DM, INC, (bf16*)(wl + OFF_WIN), kb * 64, n0, dst, scr, F.lane, in[1] + l * DM); continue; } r -= I_IN;
        if (r < I_GLU) { const int kb = r / 16, nb = r % 16; transpose_item(in[16] + (size_t)l * SW * SW, SW, SW, (bf16*)(wl + OFF_GLUW), kb * 64, nb * 32, nb * 32, scr, F.lane); continue; } r -= I_GLU;
        if (r < I_OUT) { const int kb = r / 32, nb = r % 32; transpose_item(in[18] + (size_t)l * DM * DM, DM, DM, (bf16*)(wl + OFF_WOUT), kb * 64, nb * 32, nb * 32, scr, F.lane); continue; } r -= I_OUT;
        if (r < I_GT) { const int kb = r / 88, nb = r % 88; transpose_item(in[21] + (size_t)l * DM * FF, DM, FF, (bf16*)(wl + OFF_WGU), kb * 64, nb * 32, glu_row(nb * 32), scr, F.lane, in[19] + l * DM); continue; } r -= I_GT;
        if (r < I_GT) { const int kb = r / 88, nb = r % 88; transpose_item(in[22] + (size_t)l * DM * FF, DM, FF, (bf16*)(wl + OFF_WGU), kb * 64, nb * 32, glu_row(nb * 32) + 128, scr, F.lane, in[19] + l * DM); continue; } r -= I_GT;
        { const int kb = r / 32, nb = r % 32; transpose_item(in[23] + (size_t)l * FF * DM, FF, DM, (bf16*)(wl + OFF_WDN), kb * 64, nb * 32, nb * 32, scr, F.lane); }
    }
    __syncthreads();
    if (F.vcu < DEPTH * NG) s5_build(F, in, ws, F.vcu / NG, F.vcu % NG);
    e_phase<0>(F, in[0], (bf16*)(ws + WS_H), nullptr, nullptr, nullptr, (float*)(ws + WS_RSS), nullptr);
}

__device__ __forceinline__ void conv_phase(const Frame& F, const bf16* CG, bf16* CAT, const float* dw_w, const float* dw_b, const float* ln_g, const float* ln_b) {
    LAS unsigned* it = (LAS unsigned*)F.lds;
    LAS float* yt = (LAS float*)(F.lds + 63488);
    int tid_ = F.tid; asm volatile("" : "+v"(tid_));
    const int tid = tid_, cp = tid & 255, th = tid >> 8, lane = tid & 63, wave = tid >> 6;
    f32x2 w[KC];
#pragma unroll
    for (int j = 0; j < KC; ++j) w[j] = *(const f32x2*)(dw_w + j * CW + 2 * cp);
    const f32x2 bias = *(const f32x2*)(dw_b + 2 * cp);
    f32x4 lg[2], lb[2];
#pragma unroll
    for (int j = 0; j < 2; ++j) { lg[j] = *(const f32x4*)(ln_g + 8 * lane + 4 * j); lb[j] = *(const f32x4*)(ln_b + 8 * lane + 4 * j); }
    v4u pf[8];
#define CONV_LOAD(uu) do { const int b_ = (uu) >> 8, t0_ = ((uu) & 255) * 32; _Pragma("unroll") for (int i = 0; i < 8; ++i) { const int idx = tid + i * 512, row = idx >> 6, c16 = idx & 63, tok = t0_ - 15 + row; \
        pf[i] = (v4u){0u, 0u, 0u, 0u}; if (idx < 62 * 64 && tok >= 0 && tok < SEQ) pf[i] = *(const v4u*)(CG + ((size_t)(b_ * SEQ + tok) * CW + c16 * 8)); } } while (0)
    const int ub = (F.vcu >> 5) * 256 + (F.vcu & 31);
    CONV_LOAD(ub);
    for (int kk = 0; kk < 8; ++kk) { const int u = ub + 32 * kk;
        const int b = u >> 8, t0 = (u & 255) * 32;
#pragma unroll
        for (int i = 0; i < 8; ++i) { const int idx = tid + i * 512; if (idx < 62 * 64) *(LAS v4u*)(it + idx * 4) = pf[i]; }
        __syncthreads();
        if (kk + 1 < 8) CONV_LOAD(u + 32);
        {
            f32x2 a[16];
#pragma unroll
            for (int tt = 0; tt < 16; ++tt) a[tt] = bias;
            unsigned xin[46];
#pragma unroll
            for (int r = 0; r < 46; ++r) xin[r] = it[(th * 16 + r) * 256 + cp];
#pragma unroll
            for (int r = 0; r < 46; ++r) {
                const unsigned v = xin[r]; const f32x2 x = (f32x2){bf_lo(v), bf_hi(v)};
#pragma unroll
                for (int tt = 0; tt < 16; ++tt) { const int j = r - tt; if (j >= 0 && j < KC) a[tt] += w[j] * x; }
            }
#pragma unroll
            for (int tt = 0; tt < 16; ++tt) *(LAS f32x2*)(yt + (th * 16 + tt) * 512 + 2 * cp) = a[tt];
        }
        __syncthreads();
        {
            f32x4 v0[4], v1[4]; float s1[4], s2[4];
#pragma unroll
            for (int q = 0; q < 4; ++q) { const int t = wave * 4 + q; v0[q] = *(const LAS f32x4*)(yt + t * 512 + 8 * lane); v1[q] = *(const LAS f32x4*)(yt + t * 512 + 8 * lane + 4); }
#pragma unroll
            for (int q = 0; q < 4; ++q) {
                s1[q] = (v0[q][0] + v0[q][1]) + (v0[q][2] + v0[q][3]) + (v1[q][0] + v1[q][1]) + (v1[q][2] + v1[q][3]);
                s2[q] = (v0[q][0] * v0[q][0] + v0[q][1] * v0[q][1]) + (v0[q][2] * v0[q][2] + v0[q][3] * v0[q][3]) + (v1[q][0] * v1[q][0] + v1[q][1] * v1[q][1]) + (v1[q][2] * v1[q][2] + v1[q][3] * v1[q][3]);
            }
#pragma unroll
            for (int q = 0; q < 4; ++q) { s1[q] = wave_sum_dpp(s1[q]); s2[q] = wave_sum_dpp(s2[q]); }
#pragma unroll
            for (int q = 0; q < 4; ++q) {
                const int t = wave * 4 + q;
                const float mu = s1[q] * (1.0f / CW), var = fmaxf(s2[q] * (1.0f / CW) - mu * mu, 0.f), rs = __builtin_amdgcn_rsqf(var + EPS);
                float o[8];
#pragma unroll
                for (int e = 0; e < 4; ++e) { const float y0 = (v0[q][e] - mu) * rs * lg[0][e] + lb[0][e], y1 = (v1[q][e] - mu) * rs * lg[1][e] + lb[1][e]; o[e] = y0 * sigmoid_f(y0); o[4 + e] = y1 * sigmoid_f(y1); }
                v4u wv; wv.x = cvt_pk_bf16(o[0], o[1]); wv.y = cvt_pk_bf16(o[2], o[3]); wv.z = cvt_pk_bf16(o[4], o[5]); wv.w = cvt_pk_bf16(o[6], o[7]);
                *(v4u*)(CAT + ((size_t)(b * SEQ + t0 + t) * DM + 8 * lane)) = wv;
            }
        }
    }
#undef CONV_LOAD
    __syncthreads();
}

__device__ __forceinline__ void scan_phase(const Frame& F, const float* S, bf16* A2, const f32x2* AT, int l) {
    int tid_ = F.tid; asm volatile("" : "+v"(tid_));
    if (tid_ >= 128) return;
    for (int blk = F.vcu; blk < NG * NB; blk += F.G) {
        const int g = blk >> 3, b = blk & 7, d = tid_ >> 6, p = tid_ & 63;
        const f32x2 a = AT[((l * NG + g) * 2 + d) * NP + p];
        const size_t row0 = (size_t)g * RPG + b * 256;
        float xr = 0.f, xi = 0.f;
        for (int c0 = 0; c0 < 256; c0 += 16) {
            float sr[16], si[16];
#pragma unroll
            for (int i = 0; i < 16; ++i) { const int c = d == 0 ? c0 + i : 255 - (c0 + i); const float* sp = S + (row0 + c) * 256 + d * 128 + p; sr[i] = sp[0]; si[i] = sp[64]; }
#pragma unroll
            for (int i = 0; i < 16; ++i) { const int c = d == 0 ? c0 + i : 255 - (c0 + i); bf16* cp = A2 + (row0 + c) * K2 + 512 + d * 128 + p;
                cp[0] = (bf16)f2bf(xr); cp[64] = (bf16)f2bf(xi);
                const float nr = a.x * xr - a.y * xi + sr[i]; xi = a.x * xi + a.y * xr + si[i]; xr = nr; }
        }
    }
}

struct Args { const float* in[24]; float* out; unsigned char* ws; int ph_lo, ph_hi; };
constexpr int PH_PER_LAYER = 10, N_PHASES = 1 + DEPTH * PH_PER_LAYER;

__global__ void __launch_bounds__(NTHR, 2) fwd_kernel(Args args) {
    extern __shared__ __attribute__((aligned(16))) unsigned char lds_raw[];
    Frame F;
    F.lds = (LAS unsigned char*)lds_raw;
    F.tid = threadIdx.x; F.lane = F.tid & 63; F.wave = __builtin_amdgcn_readfirstlane(F.tid >> 6);
    F.G = gridDim.x; { const int bx = blockIdx.x; F.vcu = (F.G % 8 == 0) ? (bx % 8) * (F.G / 8) + bx / 8 : bx; }
    unsigned char* ws = args.ws;
    const float* const* in = args.in;
    const int lo = args.ph_lo, hi = args.ph_hi;
    cg::grid_group grid = cg::this_grid();
    volatile LAS unsigned* bst = (volatile LAS unsigned*)(F.lds + LDS_BYTES - 64);
    if (F.tid < 16) bst[F.tid] = 0u;
    __syncthreads();
    (void)xcd_barrier_post((unsigned*)(ws + WS_BAR), bst, gridDim.x);
    (void)xcd_barrier_post((unsigned*)(ws + WS_BAR) + (1 + (blockIdx.x & 7)) * BAR_REGION_WORDS, bst + 2, gridDim.x >> 3);
    (void)xcd_barrier_post((unsigned*)(ws + WS_BAR) + (9 + (blockIdx.x & 7) * 8 + ((blockIdx.x >> 3) & 7)) * BAR_REGION_WORDS, bst + 4, gridDim.x >> 6);
#define GROUP_BAR() do { XcdBarrier b_; b_.bar = (unsigned*)(args.ws + WS_BAR) + (9 + (blockIdx.x & 7) * 8 + ((blockIdx.x >> 3) & 7)) * BAR_REGION_WORDS; b_.x = xb_xcc_id(); b_.st = (volatile LAS unsigned*)(F.lds + LDS_BYTES - 64) + 4; b_.G = gridDim.x >> 6; xcd_barrier(b_); } while (0)
#define GRID_BAR() do { XcdBarrier b_; b_.bar = (unsigned*)(args.ws + WS_BAR); b_.x = xb_xcc_id(); b_.st = (volatile LAS unsigned*)(F.lds + LDS_BYTES - 64); b_.G = gridDim.x; xcd_barrier(b_); } while (0)
#define CLASS_BAR() do { XcdBarrier b_; b_.bar = (unsigned*)(args.ws + WS_BAR) + (1 + (blockIdx.x & 7)) * BAR_REGION_WORDS; b_.x = xb_xcc_id(); b_.st = (volatile LAS unsigned*)(F.lds + LDS_BYTES - 64) + 2; b_.G = gridDim.x >> 3; xcd_barrier(b_); } while (0)
    if (args.ph_lo < 0) grid.sync();
#define IN(k) (lo <= (k) && (k) < hi)
#ifndef REPMASK
#define REPMASK 0u
#endif
#define REPS(j) (((REPMASK >> (j)) & 1u) ? 2 : 1)
#define SEAM(k) do { if (IN(k) && IN((k) + 1)) { if ((k) == 0) GRID_BAR(); else CLASS_BAR(); } } while (0)
#define SEAM_GROUP(k) do { if (IN(k) && IN((k) + 1)) { GROUP_BAR(); } } while (0)

    for (int rep = 0; rep < REPS(0); ++rep) { if (rep) GRID_BAR(); if (IN(0)) { p0_prologue(F, in, ws); } } SEAM(0);

    bf16* const H = (bf16*)(ws + WS_H); float* const RSS = (float*)(ws + WS_RSS);
    bf16* const ACT = (bf16*)(ws + WS_BIG);
    bf16* const CGb = (bf16*)(ws + WS_CG); bf16* const Zb = (bf16*)(ws + WS_Z); bf16* const A2 = (bf16*)(ws + WS_A2); bf16* const CAT = (bf16*)(ws + WS_CAT);

    for (int l = 0; l < DEPTH; ++l) {
        const int pb = 1 + l * PH_PER_LAYER;
        const unsigned char* wl = ws + WS_WL + (size_t)l * WL_STRIDE;
        const unsigned char* s5 = ws + WS_S5 + (size_t)l * S5_STRIDE;
        for (int rep = 0; rep < ((0 != 6 || l == 0) ? REPS(1) : 1); ++rep) { if (rep) GRID_BAR();
        if (IN(pb + 0)) {
            pg8::Gemm g{H, (const bf16*)(wl + OFF_WIN), DM, DM, DM}; pg8::StaticOrder S; S.init(M, INC, F.G, (int)blockIdx.x);
            EpiProj E{CGb, A2, RSS}; pg8::gemm_phase(F.lds, g, S, E);
        } } SEAM(pb + 0);
        { for (int step = 0; step < 2; ++step) { if (((step ^ (int)blockIdx.x) & 1) == 0) { conv_phase(F, CGb, CAT, in[4] + l * KC * CW, in[5] + l * CW, in[6] + l * CW, in[7] + l * CW); } else
        if (IN(pb + 1)) {
            pg8::Gemm g{A2, (const bf16*)(s5 + OFF_BS), K2, 512, 512}; OrderS1 S{F.vcu}; EpiScan E{A2, (const f32x2*)(ws + WS_AT), l}; pg8::gemm_phase(F.lds, g, S, E);
            __builtin_amdgcn_fence(__ATOMIC_ACQUIRE, "agent"); asm volatile("s_waitcnt vmcnt(0)" ::: "memory"); __syncthreads();
            pg8::Gemm g2{A2, (const bf16*)(s5 + OFF_B2), K2, K2, K2}; OrderS2 S2{F.vcu}; EpiS5 E2{Zb}; pg8::gemm_phase(F.lds, g2, S2, E2);
        } } } SEAM(pb + 1);
        for (int rep = 0; rep < ((2 != 6 || l == 0) ? REPS(3) : 1); ++rep) { if (rep) GRID_BAR();
        if (IN(pb + 2)) { } }
        for (int rep = 0; rep < ((3 != 6 || l == 0) ? REPS(4) : 1); ++rep) { if (rep) GRID_BAR();
        if (IN(pb + 3)) {
        } }
        for (int rep = 0; rep < ((4 != 6 || l == 0) ? REPS(5) : 1); ++rep) { if (rep) GRID_BAR();
        if (IN(pb + 4)) {
            pg8::Gemm g{Zb, (const bf16*)(wl + OFF_GLUW), SW, SW, SW}; pg8::StaticOrder S; S.init(M, SW, F.G, (int)blockIdx.x);
            EpiGate E{Zb, CAT, in[17] + l * SW}; pg8::gemm_phase(F.lds, g, S, E);
        } } SEAM_GROUP(pb + 4);
        for (int rep = 0; rep < 1; ++rep) { if (rep) GRID_BAR();
        if (IN(pb + 5)) {
            pg8::Gemm g{CAT, (const bf16*)(wl + OFF_WOUT), DM, DM, DM}; pg8::StaticOrder S; S.init(M, DM, F.G, (int)blockIdx.x);
            EpiResNorm<false> E{H, in[2] + l * DM, (unsigned long long*)(ws + WS_XB), (unsigned)(2 * l + 1), RSS, nullptr}; pg8::gemm_phase(F.lds, g, S, E);
        } } SEAM_GROUP(pb + 5);
        for (int rep = 0; rep < 1; ++rep) { if (rep) GRID_BAR();
        if (IN(pb + 6)) { } }
        for (int rep = 0; rep < ((7 != 6 || l == 0) ? REPS(8) : 1); ++rep) { if (rep) GRID_BAR();
        if (IN(pb + 7)) {
            pg8::Gemm g{H, (const bf16*)(wl + OFF_WGU), DM, DM, DM}; OrderG4 S{(int)blockIdx.x};
            EpiSwiGLU E{ACT, RSS}; pg8::gemm_phase(F.lds, g, S, E);
        } } SEAM_GROUP(pb + 7);
        for (int rep = 0; rep < 1; ++rep) { if (rep) GRID_BAR();
        if (IN(pb + 8)) {
            pg8::Gemm g{ACT, (const bf16*)(wl + OFF_WDN), FF, FF, FF}; pg8::StaticOrder S; S.init(M, DM, F.G, (int)blockIdx.x);
            const unsigned cn = (unsigned)(2 * l + 2);
            if (l + 1 < DEPTH) { EpiResNorm<false> E{H, in[20] + l * DM, (unsigned long long*)(ws + WS_XB), cn, RSS, nullptr}; pg8::gemm_phase(F.lds, g, S, E); }
            else { EpiResNorm<true> E{H, in[20] + l * DM, (unsigned long long*)(ws + WS_XB), cn, nullptr, args.out}; pg8::gemm_phase(F.lds, g, S, E); }
        } } if (l + 1 < DEPTH) SEAM_GROUP(pb + 8);
        for (int rep = 0; rep < ((9 != 6 || l == 0) ? REPS(10) : 1); ++rep) { if (rep) GRID_BAR();
        if (IN(pb + 9)) { } }
    }
#undef IN
#undef SEAM
}

#ifndef MK_PER_PHASE
#define MK_PER_PHASE 0
#endif
extern "C" void kernel_launch(void* const* d_in, const int* in_sizes, int n_in, void* d_out, int out_size, void* d_ws, size_t ws_size, hipStream_t stream) {
    static int grid = 0;
    if (grid == 0) {
        if (n_in != 24 || in_sizes[0] != M * DM || out_size != M * DM || ws_size < WS_END) { fprintf(stderr, "kernel_launch: unexpected shapes (n_in %d, in0 %d, out %d, ws %zu)\n", n_in, n_in > 0 ? in_sizes[0] : -1, out_size, ws_size); grid = -1; return; }
        int dev = 0, cus = 0, per_cu = 0;
        if (hipGetDevice(&dev) != hipSuccess || hipDeviceGetAttribute(&cus, hipDeviceAttributeMultiprocessorCount, dev) != hipSuccess) { grid = -1; return; }
        if (hipFuncSetAttribute((const void*)fwd_kernel, hipFuncAttributeMaxDynamicSharedMemorySize, LDS_BYTES) != hipSuccess) { fprintf(stderr, "kernel_launch: hipFuncSetAttribute failed\n"); grid = -1; return; }
        if (hipOccupancyMaxActiveBlocksPerMultiprocessor(&per_cu, (const void*)fwd_kernel, NTHR, LDS_BYTES) != hipSuccess || per_cu < 1) { fprintf(stderr, "kernel_launch: occupancy query says %d\n", per_cu); per_cu = 1; }
        (void)hipGetLastError();
        grid = cus;
        if (grid > 256) grid = 256;
    }
    if (grid < 0) return;
    if (hipMemsetAsync((char*)d_ws + WS_BAR, 0, BAR_BYTES, stream) != hipSuccess) { fprintf(stderr, "kernel_launch: memset of barrier words failed\n"); return; }
    Args a{};
    for (int i = 0; i < 24; ++i) a.in[i] = (const float*)d_in[i];
    a.out = (float*)d_out; a.ws = (unsigned char*)d_ws;
#if MK_PER_PHASE
    for (int ph = 0; ph < N_PHASES; ++ph) {
        a.ph_lo = ph; a.ph_hi = ph + 1;
        void* kargs[] = {&a};
        hipError_t e = hipLaunchCooperativeKernel((const void*)fwd_kernel, dim3(grid), dim3(NTHR), kargs, LDS_BYTES, stream);
        if (e != hipSuccess) { fprintf(stderr, "launch phase %d failed: %s\n", ph, hipGetErrorString(e)); break; }
    }
#else
    a.ph_lo = 0; a.ph_hi = N_PHASES;
    void* kargs[] = {&a};
    hipError_t e = hipLaunchCooperativeKernel((const void*)fwd_kernel, dim3(grid), dim3(NTHR), kargs, LDS_BYTES, stream);
    if (e != hipSuccess) fprintf(stderr, "cooperative launch failed: %s (grid %d)\n", hipGetErrorString(e), grid);
#endif
}
```
